# Optimizing an MI355X kernel written in HIP

```python
import math
import jax, jax.numpy as jnp
from jax import lax
import numpy as np

D_MODEL = 1024
BATCH = 8
SEQ = 2048
DEPTH = 1

RET_HEADS = 4
RET_DK = 64
RET_DV = 128
RET_CHUNK = 128
RET_ROPE_BASE = 10000.0
SWA_HEADS = 8
SWA_KV_HEADS = 2
SWA_HEAD_DIM = 64
SWA_GROUP = SWA_HEADS // SWA_KV_HEADS
WINDOW = 128
SWA_BLOCK = WINDOW
NUM_BUCKETS = 32
MAX_DISTANCE = 128
RET_QK = RET_HEADS * RET_DK
RET_V = RET_HEADS * RET_DV
SWA_Q = SWA_HEADS * SWA_HEAD_DIM
SWA_KV = SWA_KV_HEADS * SWA_HEAD_DIM
D_MIX = RET_V + SWA_Q
SPLIT_SIZES = (RET_QK, RET_QK, RET_V, RET_V, SWA_Q, SWA_KV, SWA_KV, SWA_Q)
D_IN = sum(SPLIT_SIZES)
NORM_EPS = 1e-6
GN_EPS = 1e-5
NEG_INF = -1e30

kernel_name = "hybrid_retention_swa_sink_layer"


def rms_norm(x, w, eps=NORM_EPS):
    xf = x.astype(jnp.float32)
    y = xf * lax.rsqrt(jnp.mean(xf * xf, axis=-1, keepdims=True) + eps)
    return y * w.astype(jnp.float32)


def rotary(t, base):
    S, d = t.shape[1], t.shape[-1]
    half = d // 2
    inv_freq = base ** (-jnp.arange(half, dtype=jnp.float32) / half)
    ang = jnp.arange(S, dtype=jnp.float32)[:, None] * inv_freq[None, :]
    cos = jnp.cos(ang)[None, :, None, :]
    sin = jnp.sin(ang)[None, :, None, :]
    t1, t2 = t[..., :half], t[..., half:]
    return jnp.concatenate([t1 * cos - t2 * sin, t1 * sin + t2 * cos], axis=-1)


def retention(q, k, v):
    B, S = q.shape[0], q.shape[1]
    N, C, H = S // RET_CHUNK, RET_CHUNK, RET_HEADS
    k = k * (RET_DK ** -0.5)

    def chunks(t):
        return t.reshape(B, N, C, H, t.shape[-1]).transpose(0, 3, 1, 2, 4)

    qc, kc, vc = chunks(q), chunks(k), chunks(v)
    gamma = 1.0 - jnp.exp2(-5.0 - jnp.arange(H, dtype=jnp.float32))
    log_g = jnp.log(gamma)
    i = jnp.arange(C, dtype=jnp.float32)
    diff = i[:, None] - i[None, :]
    decay = jnp.where(diff >= 0, jnp.exp(log_g[:, None, None] * jnp.maximum(diff, 0.0)), 0.0)
    scores = jnp.einsum('bhnid,bhnjd->bhnij', qc, kc) * decay[None, :, None]
    intra = jnp.einsum('bhnij,bhnje->bhnie', scores, vc)
    zeta = jnp.exp(log_g[:, None] * (C - 1.0 - i))
    kv = jnp.einsum('bhnjd,bhnje->nbhde', kc * zeta[None, :, None, :, None], vc)
    chunk_decay = jnp.exp(log_g * C)[None, :, None, None]

    def step(state, kv_n):
        return chunk_decay * state + kv_n, state

    _, prev = lax.scan(step, jnp.zeros((B, H, RET_DK, RET_DV), jnp.float32), kv)
    xi = jnp.exp(log_g[:, None] * (i + 1.0))
    cross = jnp.einsum('bhnid,nbhde->bhnie', qc * xi[None, :, None, :, None], prev)
    return (intra + cross).transpose(0, 2, 3, 1, 4).reshape(B, S, H, RET_DV)


def t5_bucket(n):
    max_exact = NUM_BUCKETS // 2
    nf = jnp.maximum(n, 1).astype(jnp.float32)
    large = max_exact + (jnp.log(nf / max_exact) / math.log(MAX_DISTANCE / max_exact)
                         * (NUM_BUCKETS - max_exact)).astype(jnp.int32)
    large = jnp.minimum(large, NUM_BUCKETS - 1)
    return jnp.where(n < max_exact, n, large)


def sliding_window_attention(q, k, v, q_norm_w, k_norm_w, sinks, rel_bias):
    B, S = q.shape[0], q.shape[1]
    N, C = S // SWA_BLOCK, SWA_BLOCK
    q = rms_norm(q, q_norm_w)
    k = rms_norm(k, k_norm_w)
    qb = q.reshape(B, N, C, SWA_KV_HEADS, SWA_GROUP, SWA_HEAD_DIM)

    def band(t):
        tb = t.reshape(B, N, C, SWA_KV_HEADS, SWA_HEAD_DIM)
        prev = jnp.pad(tb, ((0, 0), (1, 0), (0, 0), (0, 0), (0, 0)))[:, :-1]
        return jnp.concatenate([prev, tb], axis=2)

    kband, vband = band(k), band(v)
    logits = jnp.einsum('bnqhgd,bnkhd->bhgnqk', qb, kband) * (SWA_HEAD_DIM ** -0.5)
    qi = jnp.arange(C)[:, None]
    kj = jnp.arange(2 * C)[None, :]
    dist = qi + C - kj
    bucket = t5_bucket(jnp.maximum(dist, 0))
    bias = rel_bias[bucket].astype(jnp.float32).transpose(2, 0, 1)
    bias = bias.reshape(SWA_KV_HEADS, SWA_GROUP, 1, C, 2 * C)
    key_pos = jnp.arange(N)[:, None, None] * C - C + kj[None]
    mask = (dist[None] >= 0) & (dist[None] < WINDOW) & (key_pos >= 0)
    logits = jnp.where(mask, logits + bias, NEG_INF)
    sink = jnp.broadcast_to(sinks.astype(jnp.float32).reshape(SWA_KV_HEADS, SWA_GROUP, 1, 1, 1),
                            logits.shape[:-1] + (1,))
    probs = jax.nn.softmax(jnp.concatenate([logits, sink], axis=-1), axis=-1)[..., :-1]
    out = jnp.einsum('bhgnqk,bnkhd->bnqhgd', probs, vband)
    return out.reshape(B, S, SWA_Q)


def setup_inputs(seed: int = 0) -> dict:
    key = jax.random.key(seed)
    ks = jax.random.split(key, 9)
    f32 = jnp.float32
    x = jax.random.normal(ks[0], (BATCH, SEQ, D_MODEL), f32)
    norm_w = 1.0 + 0.02 * jax.random.normal(ks[1], (D_MODEL,), f32)
    w_in = jax.random.normal(ks[2], (D_MODEL, D_IN), f32) * D_MODEL ** -0.5
    ret_norm_w = 1.0 + 0.02 * jax.random.normal(ks[3], (RET_V,), f32)
    q_norm_w = 1.0 + 0.02 * jax.random.normal(ks[4], (SWA_HEAD_DIM,), f32)
    k_norm_w = 1.0 + 0.02 * jax.random.normal(ks[5], (SWA_HEAD_DIM,), f32)
    sinks = 0.5 * jax.random.normal(ks[6], (SWA_HEADS,), f32)
    rel_bias = 0.1 * jax.random.normal(ks[7], (NUM_BUCKETS, SWA_HEADS), f32)
    w_out = jax.random.normal(ks[8], (D_MIX, D_MODEL), f32) * D_MIX ** -0.5
    return {"x": x, "norm_w": norm_w, "w_in": w_in, "ret_norm_w": ret_norm_w,
            "q_norm_w": q_norm_w, "k_norm_w": k_norm_w, "sinks": sinks,
            "rel_bias": rel_bias, "w_out": w_out}


def reference(x, norm_w, w_in, ret_norm_w, q_norm_w, k_norm_w, sinks, rel_bias, w_out):
    B, S = x.shape[0], x.shape[1]
    offsets = []
    acc = 0
    for sz in SPLIT_SIZES[:-1]:
        acc += sz
        offsets.append(acc)
    for _ in range(DEPTH):
        h = rms_norm(x, norm_w).astype(x.dtype)
        proj = jnp.einsum('bsd,de->bse', h, w_in).astype(jnp.float32)
        rq, rk, rv, rg, sq, sk, sv, sg = jnp.split(proj, offsets, axis=-1)
        rq = rotary(rq.reshape(B, S, RET_HEADS, RET_DK), RET_ROPE_BASE)
        rk = rotary(rk.reshape(B, S, RET_HEADS, RET_DK), RET_ROPE_BASE)
        ro = retention(rq, rk, rv.reshape(B, S, RET_HEADS, RET_DV))
        mu = jnp.mean(ro, axis=-1, keepdims=True)
        var = jnp.mean(jnp.square(ro - mu), axis=-1, keepdims=True)
        ro = ((ro - mu) * lax.rsqrt(var + GN_EPS)).reshape(B, S, RET_V) * ret_norm_w.astype(jnp.float32)
        ro = ro * jax.nn.silu(rg)
        so = sliding_window_attention(
            sq.reshape(B, S, SWA_HEADS, SWA_HEAD_DIM),
            sk.reshape(B, S, SWA_KV_HEADS, SWA_HEAD_DIM),
            sv.reshape(B, S, SWA_KV_HEADS, SWA_HEAD_DIM),
            q_norm_w, k_norm_w, sinks, rel_bias)
        so = so * jax.nn.silu(sg)
        mixed = jnp.concatenate([ro, so], axis=-1).astype(x.dtype)
        x = x + jnp.einsum('bse,ed->bsd', mixed, w_out)
    return x
```

```cpp
#include <hip/hip_runtime.h>
#include <cstdio>
#include <cstdint>
#include <cmath>

constexpr int DM = 1024, BATCH = 8, SEQ = 2048, T = BATCH * SEQ;
constexpr int RH = 4, RDK = 64, RDV = 128, CH = 128, NCH = SEQ / CH;
constexpr int SH = 8, SKV = 2, SD = 64, SG = 4, WIN = 128;
constexpr int NBKT = 32;
constexpr int O_RQ = 0, O_RK = 256, O_RV = 512, O_RG = 1024, O_SQ = 1536, O_SK = 2048, O_SV = 2176, O_SG = 2304, DIN = 2816;
constexpr int DMIX = 1024;
constexpr float NORM_EPS = 1e-6f, GN_EPS = 1e-5f;

constexpr size_t MiB = 1u << 20;
constexpr size_t WS_CTL = 0;
constexpr size_t WS_TAB = 1 * MiB;
constexpr size_t WS_RSTD = 10 * MiB;
constexpr size_t WS_KV = 12 * MiB;
constexpr size_t WS_P = 64 * MiB;
constexpr size_t WS_MIX = 152 * MiB;
constexpr size_t WS_END = 184 * MiB;

typedef unsigned short bf16_t;
__device__ __forceinline__ bf16_t f2bf(float f) { unsigned u = __float_as_uint(f); return (bf16_t)((u + 0x7fffu + ((u >> 16) & 1u)) >> 16); }
__device__ __forceinline__ float bf2f(bf16_t b) { return __uint_as_float(((unsigned)b) << 16); }
__device__ __forceinline__ float silu_f(float v) { return v / (1.f + __expf(-v)); }

struct Tabs { float* cosT; float* sinT; float* biasT; };
__host__ __device__ inline Tabs tabs_of(unsigned char* ws) { Tabs t; t.cosT = (float*)(ws + WS_TAB); t.sinT = t.cosT + SEQ * 32; t.biasT = t.sinT + SEQ * 32; return t; }

__global__ void __launch_bounds__(256) k_prep(const float* x, const float* rel_bias, unsigned char* ws) {
    Tabs tb = tabs_of(ws);
    float* rstd = (float*)(ws + WS_RSTD);
    const int gtid = blockIdx.x * 256 + threadIdx.x, nth = gridDim.x * 256;
    for (int i = gtid; i < SEQ * 32; i += nth) {
        const int s = i >> 5, d = i & 31;
        const float inv_freq = powf(10000.0f, -(float)d / 32.0f);
        const float ang = (float)s * inv_freq;
        float sn, cs; sincosf(ang, &sn, &cs);
        tb.cosT[i] = cs; tb.sinT[i] = sn;
    }
    for (int i = gtid; i < SH * WIN; i += nth) {
        const int hq = i >> 7, dist = i & 127;
        int bucket;
        if (dist < 16) bucket = dist;
        else { const float nf = (float)dist; int large = 16 + (int)(logf(nf / 16.0f) / 2.0794415416798357f * 16.0f); bucket = large < 31 ? large : 31; }
        tb.biasT[i] = rel_bias[bucket * SH + hq];
    }
    const int wave = gtid >> 6, lane = threadIdx.x & 63, nw = nth >> 6;
    for (int t = wave; t < T; t += nw) {
        const float4* xr = (const float4*)(x + (size_t)t * DM);
        float s = 0.f;
        for (int j = 0; j < 4; ++j) { const float4 v = xr[lane + 64 * j]; s += v.x * v.x + v.y * v.y + v.z * v.z + v.w * v.w; }
        for (int o = 1; o < 64; o <<= 1) s += __shfl_xor(s, o);
        if (lane == 0) rstd[t] = 1.0f / sqrtf(s * (1.0f / DM) + NORM_EPS);
    }
}

struct GemmArgs {
    const float* x; const float* norm_w; const float* w; const float* q_norm_w; const float* k_norm_w;
    unsigned char* ws; float* out; float lg2g[4];
};
template <int MODE>
__global__ void __launch_bounds__(256) k_gemm(GemmArgs a) {
    __shared__ float As[16][64 + 4];
    __shared__ float Bs[16][64 + 4];
    __shared__ float Cs[64][65];
    const int tid = threadIdx.x, tx = tid & 15, ty = tid >> 4;
    const int col0 = blockIdx.x * 64, row0 = blockIdx.y * 64;
    constexpr int K = (MODE == 1) ? DM : DMIX;
    constexpr int N = (MODE == 1) ? DIN : DM;
    const bf16_t* mixed = (const bf16_t*)(a.ws + WS_MIX);
    float acc[4][4];
    for (int i = 0; i < 4; ++i) for (int j = 0; j < 4; ++j) acc[i][j] = 0.f;
    const int ar = tid >> 2, ak = (tid & 3) * 4;
    const int bk = tid >> 4, bc = (tid & 15) * 4;
    for (int k0 = 0; k0 < K; k0 += 16) {
        float av[4];
        if (MODE == 1) {
            const float4 v = *(const float4*)(a.x + (size_t)(row0 + ar) * DM + k0 + ak);
            const float4 w = *(const float4*)(a.norm_w + k0 + ak);
            av[0] = v.x * w.x; av[1] = v.y * w.y; av[2] = v.z * w.z; av[3] = v.w * w.w;
        } else {
            const bf16_t* p = mixed + (size_t)(row0 + ar) * DMIX + k0 + ak;
            av[0] = bf2f(p[0]); av[1] = bf2f(p[1]); av[2] = bf2f(p[2]); av[3] = bf2f(p[3]);
        }
        const float4 bv = *(const float4*)(a.w + (size_t)(k0 + bk) * N + col0 + bc);
        __syncthreads();
        for (int i = 0; i < 4; ++i) As[ak + i][ar] = av[i];
        Bs[bk][bc + 0] = bv.x; Bs[bk][bc + 1] = bv.y; Bs[bk][bc + 2] = bv.z; Bs[bk][bc + 3] = bv.w;
        __syncthreads();
#pragma unroll
        for (int k = 0; k < 16; ++k) {
            float ra[4], rb[4];
            for (int i = 0; i < 4; ++i) ra[i] = As[k][ty * 4 + i];
            for (int j = 0; j < 4; ++j) rb[j] = Bs[k][tx * 4 + j];
            for (int i = 0; i < 4; ++i) for (int j = 0; j < 4; ++j) acc[i][j] = fmaf(ra[i], rb[j], acc[i][j]);
        }
    }
    if (MODE == 2) {
        for (int i = 0; i < 4; ++i) {
            const size_t off = (size_t)(row0 + ty * 4 + i) * DM + col0 + tx * 4;
            const float4 xv = *(const float4*)(a.x + off);
            float4 o; o.x = xv.x + acc[i][0]; o.y = xv.y + acc[i][1]; o.z = xv.z + acc[i][2]; o.w = xv.w + acc[i][3];
            *(float4*)(a.out + off) = o;
        }
        return;
    }
    const float* rstd = (const float*)(a.ws + WS_RSTD);
    for (int i = 0; i < 4; ++i) { const float rs = rstd[row0 + ty * 4 + i]; for (int j = 0; j < 4; ++j) Cs[ty * 4 + i][tx * 4 + j] = acc[i][j] * rs; }
    __syncthreads();
    Tabs tb = tabs_of(a.ws);
    bf16_t* P = (bf16_t*)(a.ws + WS_P);
    for (int idx = tid; idx < 64 * 64; idx += 256) {
        const int r = idx >> 6, d = idx & 63, t = row0 + r, s = t & (SEQ - 1), ci = s & (CH - 1);
        const float v = Cs[r][d];
        float o;
        if (col0 < O_RV) {
            const bool isq = col0 < O_RK; const int h = (col0 & 255) >> 6;
            const int f = d & 31; const float cs = tb.cosT[s * 32 + f], sn = tb.sinT[s * 32 + f];
            const float t1 = Cs[r][f], t2 = Cs[r][f + 32];
            const float rot = (d < 32) ? (t1 * cs - t2 * sn) : (t1 * sn + t2 * cs);
            const float e = a.lg2g[h] * (float)(ci + 1);
            o = isq ? rot * exp2f(e) : rot * 0.125f * exp2f(-e);
        } else if (col0 < O_RG) o = v;
        else if (col0 < O_SQ) o = silu_f(v);
        else if (col0 < O_SV) {
            float ss = 0.f; for (int j = 0; j < 64; ++j) { const float u = Cs[r][j]; ss += u * u; }
            const float rs = 1.0f / sqrtf(ss * (1.0f / 64.0f) + NORM_EPS);
            o = (col0 < O_SK) ? v * rs * a.q_norm_w[d] * 0.125f : v * rs * a.k_norm_w[d];
        } else if (col0 < O_SG) o = v;
        else o = silu_f(v);
        P[(size_t)t * DIN + col0 + d] = f2bf(o);
    }
}

__global__ void __launch_bounds__(64) k_swa(unsigned char* ws, const float* sinks) {
    const int gid = blockIdx.x * 64 + threadIdx.x;
    const int hq = gid / T, t = gid % T, hkv = hq >> 2, s = t & (SEQ - 1);
    const bf16_t* P = (const bf16_t*)(ws + WS_P);
    bf16_t* mixed = (bf16_t*)(ws + WS_MIX);
    Tabs tb = tabs_of(ws);
    const float* bias = tb.biasT + hq * WIN;
    float q[64];
    const bf16_t* qp = P + (size_t)t * DIN + O_SQ + hq * 64;
#pragma unroll
    for (int d = 0; d < 64; ++d) q[d] = bf2f(qp[d]);
    const int nk = (s + 1 < WIN) ? s + 1 : WIN;
    const float sink = sinks[hq];
    float m = sink;
    for (int dist = 0; dist < nk; ++dist) {
        const bf16_t* kp = P + (size_t)(t - dist) * DIN + O_SK + hkv * 64;
        float dot = 0.f;
#pragma unroll
        for (int d = 0; d < 64; ++d) dot = fmaf(q[d], bf2f(kp[d]), dot);
        const float lg = dot + bias[dist];
        m = fmaxf(m, lg);
    }
    float o[64];
#pragma unroll
    for (int d = 0; d < 64; ++d) o[d] = 0.f;
    float l = __expf(sink - m);
    for (int dist = 0; dist < nk; ++dist) {
        const bf16_t* kp = P + (size_t)(t - dist) * DIN + O_SK + hkv * 64;
        const bf16_t* vp = P + (size_t)(t - dist) * DIN + O_SV + hkv * 64;
        float dot = 0.f;
#pragma unroll
        for (int d = 0; d < 64; ++d) dot = fmaf(q[d], bf2f(kp[d]), dot);
        const float p = __expf(dot + bias[dist] - m);
        l += p;
#pragma unroll
        for (int d = 0; d < 64; ++d) o[d] = fmaf(p, bf2f(vp[d]), o[d]);
    }
    const float il = 1.0f / l;
    const bf16_t* gp = P + (size_t)t * DIN + O_SG + hq * 64;
    bf16_t* op = mixed + (size_t)t * DMIX + 512 + hq * 64;
#pragma unroll
    for (int d = 0; d < 64; ++d) op[d] = f2bf(o[d] * il * bf2f(gp[d]));
}

__global__ void __launch_bounds__(256) k_kvraw(unsigned char* ws) {
    const int bid = blockIdx.x, n = bid % NCH, h = (bid / NCH) % RH, b = bid / (NCH * RH);
    const bf16_t* P = (const bf16_t*)(ws + WS_P);
    float* kv = (float*)(ws + WS_KV) + (size_t)bid * (64 * 128);
    const size_t t0 = (size_t)b * SEQ + n * CH;
    const int tid = threadIdx.x, e = tid & 127, dh = tid >> 7;
    float acc[32];
#pragma unroll
    for (int i = 0; i < 32; ++i) acc[i] = 0.f;
    for (int j = 0; j < CH; ++j) {
        const bf16_t* kp = P + (t0 + j) * DIN + O_RK + h * 64 + dh * 32;
        const float v = bf2f(P[(t0 + j) * DIN + O_RV + h * 128 + e]);
#pragma unroll
        for (int i = 0; i < 32; ++i) acc[i] = fmaf(bf2f(kp[i]), v, acc[i]);
    }
#pragma unroll
    for (int i = 0; i < 32; ++i) kv[(dh * 32 + i) * 128 + e] = acc[i];
}

__global__ void __launch_bounds__(256) k_ret(unsigned char* ws, const float* ret_norm_w, float g128_0, float g128_1, float g128_2, float g128_3) {
    __shared__ float prev[64 * 128];
    const int bid = blockIdx.x, n = bid % NCH, h = (bid / NCH) % RH, b = bid / (NCH * RH);
    const bf16_t* P = (const bf16_t*)(ws + WS_P);
    bf16_t* mixed = (bf16_t*)(ws + WS_MIX);
    const float* kvb = (const float*)(ws + WS_KV) + (size_t)(bid - n) * (64 * 128);
    const float gC = h == 0 ? g128_0 : h == 1 ? g128_1 : h == 2 ? g128_2 : g128_3;
    const int tid = threadIdx.x;
    for (int idx = tid; idx < 64 * 128; idx += 256) {
        float s = 0.f;
        for (int m = 0; m < n; ++m) s = (s + kvb[(size_t)m * (64 * 128) + idx]) * gC;
        prev[idx] = s;
    }
    __syncthreads();
    const size_t t0 = (size_t)b * SEQ + n * CH;
    const int i = tid >> 1, half = tid & 1;
    float q[64];
    const bf16_t* qp = P + (t0 + i) * DIN + O_RQ + h * 64;
#pragma unroll
    for (int d = 0; d < 64; ++d) q[d] = bf2f(qp[d]);
    float o[64];
#pragma unroll
    for (int e = 0; e < 64; ++e) o[e] = 0.f;
#pragma unroll
    for (int d = 0; d < 64; ++d) {
        const float qd = q[d];
#pragma unroll
        for (int e = 0; e < 64; ++e) o[e] = fmaf(qd, prev[d * 128 + half * 64 + e], o[e]);
    }
    for (int j = 0; j <= i; ++j) {
        const bf16_t* kp = P + (t0 + j) * DIN + O_RK + h * 64;
        const bf16_t* vp = P + (t0 + j) * DIN + O_RV + h * 128 + half * 64;
        float dot = 0.f;
#pragma unroll
        for (int d = 0; d < 64; ++d) dot = fmaf(q[d], bf2f(kp[d]), dot);
#pragma unroll
        for (int e = 0; e < 64; ++e) o[e] = fmaf(dot, bf2f(vp[e]), o[e]);
    }
    float s1 = 0.f;
#pragma unroll
    for (int e = 0; e < 64; ++e) s1 += o[e];
    s1 += __shfl_xor(s1, 1);
    const float mu = s1 * (1.0f / 128.0f);
    float s2 = 0.f;
#pragma unroll
    for (int e = 0; e < 64; ++e) { const float dd = o[e] - mu; s2 += dd * dd; }
    s2 += __shfl_xor(s2, 1);
    const float rs = 1.0f / sqrtf(s2 * (1.0f / 128.0f) + GN_EPS);
    const bf16_t* gp = P + (t0 + i) * DIN + O_RG + h * 128 + half * 64;
    bf16_t* op = mixed + (t0 + i) * DMIX + h * 128 + half * 64;
    const float* nw = ret_norm_w + h * 128 + half * 64;
#pragma unroll
    for (int e = 0; e < 64; ++e) op[e] = f2bf((o[e] - mu) * rs * nw[e] * bf2f(gp[e]));
}

extern "C" void kernel_launch(void* const* d_in, const int* in_sizes, int n_in, void* d_out, int out_size, void* d_ws, size_t ws_size, hipStream_t stream) {
    if (n_in != 9 || in_sizes[0] != T * DM || out_size != T * DM || ws_size < WS_END) { fprintf(stderr, "kernel_launch: unexpected shapes (n_in %d, ws %zu)\n", n_in, ws_size); return; }
    const float* x = (const float*)d_in[0]; const float* norm_w = (const float*)d_in[1]; const float* w_in = (const float*)d_in[2];
    const float* ret_norm_w = (const float*)d_in[3]; const float* q_norm_w = (const float*)d_in[4]; const float* k_norm_w = (const float*)d_in[5];
    const float* sinks = (const float*)d_in[6]; const float* rel_bias = (const float*)d_in[7]; const float* w_out = (const float*)d_in[8];
    unsigned char* ws = (unsigned char*)d_ws;
    double g[4]; for (int h = 0; h < 4; ++h) g[h] = 1.0 - std::exp2(-5.0 - h);
    k_prep<<<1024, 256, 0, stream>>>(x, rel_bias, ws);
    GemmArgs a{}; a.x = x; a.norm_w = norm_w; a.w = w_in; a.q_norm_w = q_norm_w; a.k_norm_w = k_norm_w; a.ws = ws; a.out = (float*)d_out;
    for (int h = 0; h < 4; ++h) a.lg2g[h] = (float)std::log2(g[h]);
    k_gemm<1><<<dim3(DIN / 64, T / 64), 256, 0, stream>>>(a);
    k_swa<<<SH * T / 64, 64, 0, stream>>>(ws, sinks);
    k_kvraw<<<BATCH * RH * NCH, 256, 0, stream>>>(ws);
    k_ret<<<BATCH * RH * NCH, 256, 0, stream>>>(ws, ret_norm_w, (float)std::pow(g[0], 128.0), (float)std::pow(g[1], 128.0), (float)std::pow(g[2], 128.0), (float)std::pow(g[3], 128.0));
    GemmArgs a2 = a; a2.w = w_out;
    k_gemm<2><<<dim3(DM / 64, T / 64), 256, 0, stream>>>(a2);
}
```

```cpp
#include <hip/hip_runtime.h>
#include <cstdio>
#include <cstdint>
#include <cmath>

constexpr int DM = 1024, BATCH = 8, SEQ = 2048, T = BATCH * SEQ;
constexpr int RH = 4, RDK = 64, RDV = 128, CH = 128, NCH = SEQ / CH;
constexpr int SH = 8, SKV = 2, SD = 64, SG = 4, WIN = 128;
constexpr int O_RQ = 0, O_RK = 256, O_RV = 512, O_RG = 1024, O_SQ = 1536, O_SK = 2048, O_SV = 2176, O_SG = 2304, DIN = 2816;
constexpr int DMIX = 1024;
constexpr float NORM_EPS = 1e-6f, GN_EPS = 1e-5f;

constexpr size_t MiB = 1u << 20;
constexpr size_t WS_CTL = 0, CTL_ZERO_BYTES = 32768;
constexpr size_t WS_TAB = 1 * MiB;
constexpr size_t WS_W1 = 2 * MiB;
constexpr size_t WS_W2 = 8 * MiB;
constexpr size_t WS_RSTD = 10 * MiB;
constexpr size_t WS_PREV = 12 * MiB;
__device__ const unsigned char BLK_OF[44] = {24, 25, 26, 27, 28, 29, 30, 31, 32, 33, 34, 35, 36, 37, 38, 39, 4, 8, 9, 40, 5, 10, 11, 41, 6, 12, 13, 42, 7, 14, 15, 43, 0, 16, 1, 17, 2, 18, 19, 20, 3, 21, 22, 23};
__device__ const unsigned char SLOTWC_OF_BLK[44] = {32, 34, 36, 40, 16, 20, 24, 28, 17, 18, 21, 22, 25, 26, 29, 30, 33, 35, 37, 38, 39, 41, 42, 43, 0, 1, 2, 3, 4, 5, 6, 7, 8, 9, 10, 11, 12, 13, 14, 15, 19, 23, 27, 31};
constexpr unsigned long long TILE_OF_SLOT = 0x540321a9876ull;
constexpr unsigned long long SLOT_OF_TILE = 0x43210a97658ull;
constexpr size_t WS_XB = 32 * MiB;
constexpr size_t WS_P = 64 * MiB;
constexpr size_t WS_MIX = 152 * MiB;
constexpr size_t WS_END = 184 * MiB;
constexpr int CW_BAR = 4096;

typedef unsigned short bf16_t;
__device__ __forceinline__ bf16_t f2bf(float f) { unsigned u = __float_as_uint(f); return (bf16_t)((u + 0x7fffu + ((u >> 16) & 1u)) >> 16); }
__device__ __forceinline__ float bf2f(bf16_t b) { return __uint_as_float(((unsigned)b) << 16); }
__device__ __forceinline__ float silu_f(float v) { return v / (1.f + __expf(-v)); }

struct Tabs { float* cosT; float* sinT; float* biasT; };
__host__ __device__ inline Tabs tabs_of(unsigned char* ws) { Tabs t; t.cosT = (float*)(ws + WS_TAB); t.sinT = t.cosT + SEQ * 32; t.biasT = t.sinT + SEQ * 32; return t; }

namespace pg8 {
#define PG8_LAS __attribute__((address_space(3)))
typedef unsigned short bf16_t;
typedef short bf16x8 __attribute__((ext_vector_type(8)));
typedef float f32x4 __attribute__((ext_vector_type(4)));
typedef unsigned u32x4 __attribute__((ext_vector_type(4)));
constexpr int BM = 256, BK = 64, HALF = 128, HTB = HALF * BK * 2  , STAGE_BYTES = 8 * HTB, NXCD = 8, WGM = 8;

__host__ __device__ __forceinline__ int lds_byte(int r, int c) { const int st = (r >> 4) * 2 + (c >> 5), rr = r & 15, cc = c & 31, ob = rr * 64 + cc * 2; return st * 1024 + (ob ^ (((ob >> 9) & 1) << 5)); }
__host__ __device__ __forceinline__ void stage_rc(int b, int& R, int& C) { const int st = b / 1024, sb = b % 1024, swz = sb ^ (((sb >> 9) & 1) << 5); R = (st >> 1) * 16 + swz / 64; C = (st & 1) * 32 + (swz % 64) / 2; }
__host__ __device__ __forceinline__ int perm32(int rho) { const int n = rho >> 4, i = rho & 15; return 8 * (i >> 2) + 4 * n + (i & 3); }

struct Unit { int pm, pn; };
struct Gemm { const bf16_t* A; const bf16_t* Bt; int M, N, K; };

struct StaticOrder {
    int nM, nN, nwg, G, c;
    __host__ __device__ void init(int M, int N, int G_, int c_) { nM = M / BM; nN = N / BM; nwg = nM * nN; G = G_; c = c_; }
    __host__ __device__ bool next(int i, Unit& u) const {
        const long L = (long)i * G + c; if (L >= nwg) return false;
        int wgid = (int)L; { const int q = nwg / NXCD, r = nwg % NXCD, xcd = wgid % NXCD, off = wgid / NXCD; wgid = (xcd < r ? xcd * (q + 1) : r * (q + 1) + (xcd - r) * q) + off; }
        const int nig = WGM * nN, gid = wgid / nig, fm = gid * WGM, gsz = (nM - fm) < WGM ? (nM - fm) : WGM;
        u.pm = fm + ((wgid % nig) % gsz); u.pn = (wgid % nig) / gsz; return true;
    }
    __device__ __forceinline__ void a_ready(const Unit&) const {}
    __device__ __forceinline__ void done(const Unit&) const {}
};

__device__ __forceinline__ unsigned cvt_pk_bf16(float lo, float hi) { unsigned r; asm volatile("v_cvt_pk_bf16_f32 %0, %1, %2" : "=v"(r) : "v"(lo), "v"(hi)); return r; }
__device__ __forceinline__ float fast_silu(float v) { return v * __builtin_amdgcn_rcpf(1.f + __expf(-v)); }

__device__ const unsigned REVFIX[32] = {
    683565276u, 512601642u, 384397003u, 288257087u, 216162320u, 162098872u, 121557005u, 91154895u, 68356528u, 51260164u, 38439700u, 28825709u, 21616232u, 16209887u, 12155701u, 9115489u,
    6835653u, 5126016u, 3843970u, 2882571u, 2161623u, 1620989u, 1215570u, 911549u, 683565u, 512602u, 384397u, 288257u, 216162u, 162099u, 121557u, 91155u};
struct EpiProj {
    static constexpr bool PERM = true, AFTER_DRAIN = false;
    bf16_t* P; const float* rstd; const float* qnw; const float* knw; float lg2g0, lg2g1, lg2g2, lg2g3; int slot0;
    __device__ __forceinline__ void operator()(const f32x4 (&acc)[2][2][4][2], const Unit& u, int wr, int wc, int fr, int fq) const {
        const int lb = (int)BLK_OF[(slot0 + u.pn) * 4 + wc];
        const int row0 = u.pm * BM + wr * 64 + fr;
        const int lcol = lb * 64 + 8 * fq;
        int kind;
        if (lb < 4) kind = 2; else if (lb < 8) kind = 3; else if (lb < 16) kind = 0; else if (lb < 24) kind = 1; else if (lb < 32) kind = 4; else if (lb < 34) kind = 5; else if (lb < 36) kind = 0; else kind = 1;
        const int hr = lb & 3;
        const float lg2g = hr == 0 ? lg2g0 : hr == 1 ? lg2g1 : hr == 2 ? lg2g2 : lg2g3;
        float rs[2][4];
#pragma unroll
        for (int ai = 0; ai < 2; ++ai)
#pragma unroll
            for (int m = 0; m < 4; ++m) rs[ai][m] = rstd[row0 + ai * HALF + m * 16];
        f32x4 nwv[2][2];
#pragma unroll
        for (int bj = 0; bj < 2; ++bj)
#pragma unroll
            for (int n = 0; n < 2; ++n) nwv[bj][n] = (f32x4){1.f, 1.f, 1.f, 1.f};
        u32x4 rfx[2]; rfx[0] = (u32x4){0u, 0u, 0u, 0u}; rfx[1] = rfx[0];
        if (kind == 4 || kind == 5) {
            const float* nw = kind == 4 ? qnw : knw; const float sc = kind == 4 ? 0.125f * 1.4426950408889634f : 1.f;
#pragma unroll
            for (int bj = 0; bj < 2; ++bj)
#pragma unroll
                for (int n = 0; n < 2; ++n) nwv[bj][n] = *(const f32x4*)(nw + 32 * bj + 8 * fq + 4 * n) * sc;
        } else if (kind == 2 || kind == 3) {
            rfx[0] = *(const u32x4*)(REVFIX + 8 * fq); rfx[1] = *(const u32x4*)(REVFIX + 8 * fq + 4);
        }
#pragma unroll
        for (int ai = 0; ai < 2; ++ai)
#pragma unroll
            for (int m = 0; m < 4; ++m) {
                const int r = row0 + ai * HALF + m * 16;
                const float rsv = rs[ai][m];
                f32x4 v[2][2];
#pragma unroll
                for (int bj = 0; bj < 2; ++bj)
#pragma unroll
                    for (int n = 0; n < 2; ++n) v[bj][n] = acc[ai][bj][m][n] * rsv;
                if (kind == 2 || kind == 3) {
                    const unsigned sp = (unsigned)(r & (SEQ - 1)); const int ci = (int)(sp & (CH - 1));
                    const float e = lg2g * (float)(ci + 1);
                    const float sc = kind == 2 ? __builtin_amdgcn_exp2f(e) : 0.125f * __builtin_amdgcn_exp2f(-e);
#pragma unroll
                    for (int n = 0; n < 2; ++n) {
                        f32x4 cs, sn;
#pragma unroll
                        for (int j = 0; j < 4; ++j) { const float rev = (float)(sp * rfx[n][j]) * 2.3283064365386963e-10f; cs[j] = __builtin_amdgcn_cosf(rev); sn[j] = __builtin_amdgcn_sinf(rev); }
                        const f32x4 t1 = v[0][n], t2 = v[1][n];
                        v[0][n] = (t1 * cs - t2 * sn) * sc; v[1][n] = (t1 * sn + t2 * cs) * sc;
                    }
                } else if (kind == 4 || kind == 5) {
                    float ss = 0.f;
#pragma unroll
                    for (int bj = 0; bj < 2; ++bj)
#pragma unroll
                        for (int n = 0; n < 2; ++n) { const f32x4 x = v[bj][n]; ss += (x[0] * x[0] + x[1] * x[1]) + (x[2] * x[2] + x[3] * x[3]); }
                    ss += __shfl_xor(ss, 16); ss += __shfl_xor(ss, 32);
                    const float rn = 1.0f / sqrtf(ss * (1.0f / 64.0f) + NORM_EPS);
#pragma unroll
                    for (int bj = 0; bj < 2; ++bj)
#pragma unroll
                        for (int n = 0; n < 2; ++n) v[bj][n] = v[bj][n] * rn * nwv[bj][n];
                } else if (kind == 1) {
#pragma unroll
                    for (int bj = 0; bj < 2; ++bj)
#pragma unroll
                        for (int n = 0; n < 2; ++n)
#pragma unroll
                            for (int j = 0; j < 4; ++j) v[bj][n][j] = fast_silu(v[bj][n][j]);
                }
                bf16_t* rowp = P + (size_t)r * DIN + lcol;
#pragma unroll
                for (int bj = 0; bj < 2; ++bj) {
                    u32x4 w; w.x = cvt_pk_bf16(v[bj][0][0], v[bj][0][1]); w.y = cvt_pk_bf16(v[bj][0][2], v[bj][0][3]); w.z = cvt_pk_bf16(v[bj][1][0], v[bj][1][1]); w.w = cvt_pk_bf16(v[bj][1][2], v[bj][1][3]);
                    *(u32x4*)(rowp + 32 * bj) = w;
                }
            }
    }
};
struct EpiRes {
    static constexpr bool PERM = false, AFTER_DRAIN = false;
    const float* base; float* out; int ldc;
    __device__ __forceinline__ void operator()(const f32x4 (&acc)[2][2][4][2], const Unit& u, int wr, int wc, int fr, int fq) const {
        const int col0 = u.pn * BM + wc * 32 + 4 * fq;
#pragma unroll
        for (int ai = 0; ai < 2; ++ai) {
            f32x4 bs[4][2][2];
#pragma unroll
            for (int m = 0; m < 4; ++m) { const size_t off = (size_t)(u.pm * BM + ai * HALF + wr * 64 + m * 16 + fr) * ldc + col0;
#pragma unroll
                for (int bj = 0; bj < 2; ++bj)
#pragma unroll
                    for (int n = 0; n < 2; ++n) bs[m][bj][n] = __builtin_nontemporal_load((const f32x4*)(base + off + bj * HALF + n * 16)); }
#pragma unroll
            for (int m = 0; m < 4; ++m) { const size_t off = (size_t)(u.pm * BM + ai * HALF + wr * 64 + m * 16 + fr) * ldc + col0;
#pragma unroll
                for (int bj = 0; bj < 2; ++bj)
#pragma unroll
                    for (int n = 0; n < 2; ++n) *(f32x4*)(out + off + bj * HALF + n * 16) = bs[m][bj][n] + acc[ai][bj][m][n]; }
        }
    }
};

template <class Epi, class Sched, bool ALIGN_EPI = false, bool SP2 = false>
__device__ __forceinline__ void gemm_phase(PG8_LAS unsigned char* lds, const Gemm g, const Sched& S, const Epi& E) {
    const int tid = threadIdx.x, wid = __builtin_amdgcn_readfirstlane(tid >> 6), lane = tid & 63, wr = wid >> 2, wc = (wid + wr) & 3  , fr = lane & 15, fq = lane >> 4;
    const int K = g.K, nt = K / BK;
    unsigned voffA[2], voffB[2];
#pragma unroll
    for (int i = 0; i < 2; ++i) { int R, C; stage_rc(tid * 16 + i * 8192, R, C); const int Rb = Epi::PERM ? ((R & ~31) + perm32(R & 31)) : R;
        voffA[i] = (unsigned)(R * K + C) * 2u; voffB[i] = (unsigned)(Rb * K + C) * 2u; }
    const size_t kstep = (size_t)(BK * 2);
    const size_t hstep = (size_t)HALF * K * 2;
    const size_t tstep = 2 * hstep;
    const unsigned ldsw = (unsigned)wid * 1024u;
    const int aoff = lds_byte(wr * 64 + fr, fq * 8), boff = lds_byte(wc * 32 + fr, fq * 8);
#define PG8_SA(b, h) (((b) * 2 + (h)) * HTB)
#define PG8_SB(b, h) ((4 + (b) * 2 + (h)) * HTB)
#define PG8_STAGE(bufoff, gbase, voff) do { _Pragma("unroll") for (int _i = 0; _i < 2; ++_i) \
        __builtin_amdgcn_global_load_lds((const unsigned*)((const char*)(gbase) + (voff)[_i]), (PG8_LAS unsigned*)(lds + (bufoff) + ldsw + _i * 8192), 16, 0, 0); } while (0)
#define PG8_LDA(dst, b, h) do { _Pragma("unroll") for (int m = 0; m < 4; ++m) _Pragma("unroll") for (int k = 0; k < 2; ++k) dst[m][k] = *(const PG8_LAS bf16x8*)(lds + PG8_SA(b, h) + aoff + m * 2048 + k * 1024); } while (0)
#define PG8_LDB(dst, b, h) do { _Pragma("unroll") for (int n = 0; n < 2; ++n) _Pragma("unroll") for (int k = 0; k < 2; ++k) dst[n][k] = *(const PG8_LAS bf16x8*)(lds + PG8_SB(b, h) + boff + n * 2048 + k * 1024); } while (0)
#define PG8_MMA(ai, bj, At, Bt) do { __builtin_amdgcn_s_setprio(1); _Pragma("unroll") for (int m = 0; m < 4; ++m) _Pragma("unroll") for (int n = 0; n < 2; ++n) _Pragma("unroll") for (int k = 0; k < 2; ++k) \
        acc[ai][bj][m][n] = __builtin_amdgcn_mfma_f32_16x16x32_bf16(Bt[n][k], At[m][k], acc[ai][bj][m][n], 0, 0, 0); __builtin_amdgcn_s_setprio(0); } while (0)
#define PG8_WAIT_V(n) asm volatile("s_waitcnt vmcnt(" #n ")" ::: "memory")
#define PG8_WAIT_L(n) asm volatile("s_waitcnt lgkmcnt(" #n ")" ::: "memory")
#define PG8_BAR __builtin_amdgcn_s_barrier()
#define PG8_SCHED __builtin_amdgcn_sched_barrier(0)
    Unit cur, nxt; int ui = 0;
    if (!S.next(0, cur)) return;
    f32x4 acc[2][2][4][2];
#pragma unroll
    for (int a = 0; a < 2; ++a)
#pragma unroll
        for (int b = 0; b < 2; ++b)
#pragma unroll
            for (int m = 0; m < 4; ++m)
#pragma unroll
                for (int n = 0; n < 2; ++n) acc[a][b][m][n] = (f32x4){0.f, 0.f, 0.f, 0.f};
    bf16x8 At[4][2], B0[2][2], B1[2][2];
    const char* cA = (const char*)g.A + (size_t)cur.pm * tstep; const char* cB = (const char*)g.Bt + (size_t)cur.pn * tstep;
    S.a_ready(cur);
    if constexpr (SP2) {
        PG8_STAGE(PG8_SB(0, 0), cB, voffB); PG8_STAGE(PG8_SB(0, 1), cB + hstep, voffB); PG8_STAGE(PG8_SA(0, 0), cA, voffA); PG8_STAGE(PG8_SA(0, 1), cA + hstep, voffA);
        if (wr == 1) PG8_BAR;
        PG8_WAIT_V(2); PG8_BAR;
        PG8_STAGE(PG8_SB(1, 0), cB + kstep, voffB); PG8_STAGE(PG8_SA(1, 0), cA + kstep, voffA); PG8_STAGE(PG8_SB(1, 1), cB + hstep + kstep, voffB);
        PG8_WAIT_V(6); PG8_BAR;
    } else {
        PG8_STAGE(PG8_SB(0, 0), cB, voffB); PG8_STAGE(PG8_SA(0, 0), cA, voffA); PG8_STAGE(PG8_SB(0, 1), cB + hstep, voffB); PG8_STAGE(PG8_SA(0, 1), cA + hstep, voffA);
        if (wr == 1) PG8_BAR;
        PG8_WAIT_V(4); PG8_BAR;
        PG8_STAGE(PG8_SB(1, 0), cB + kstep, voffB); PG8_STAGE(PG8_SA(1, 0), cA + kstep, voffA); PG8_STAGE(PG8_SB(1, 1), cB + hstep + kstep, voffB);
        PG8_WAIT_V(6); PG8_BAR;
    }
    for (;;) {
        const bool has_next = S.next(ui + 1, nxt);
        const char* nA = has_next ? (const char*)g.A + (size_t)nxt.pm * tstep : cA; const char* nB = has_next ? (const char*)g.Bt + (size_t)nxt.pn * tstep : cB;
        for (int t = 0; t < nt; t += 2) {
            const bool last = (t == nt - 2);
            const char* a1 = cA + (size_t)(t + 1) * kstep;
            const char* a2 = last ? nA : cA + (size_t)(t + 2) * kstep; const char* b2 = last ? nB : cB + (size_t)(t + 2) * kstep;
            const char* a3 = a2 + kstep; const char* b3 = b2 + kstep;
            if (last && has_next) S.a_ready(nxt);
            if constexpr (SP2) {
            PG8_LDB(B0, 0, 0); PG8_LDB(B1, 0, 1); PG8_SCHED; PG8_LDA(At, 0, 0); PG8_STAGE(PG8_SA(1, 1), a1 + hstep, voffA);
            PG8_WAIT_V(8); PG8_WAIT_L(0); PG8_BAR; PG8_MMA(0, 0, At, B0); PG8_MMA(0, 1, At, B1); PG8_BAR; PG8_SCHED;
            PG8_LDA(At, 0, 1); PG8_STAGE(PG8_SB(0, 0), b2, voffB); PG8_STAGE(PG8_SB(0, 1), b2 + hstep, voffB); PG8_STAGE(PG8_SA(0, 0), a2, voffA);
            PG8_WAIT_V(8); PG8_WAIT_L(0); PG8_BAR; PG8_MMA(1, 0, At, B0); PG8_MMA(1, 1, At, B1); PG8_BAR; PG8_SCHED;
            PG8_LDB(B0, 1, 0); PG8_LDB(B1, 1, 1); PG8_SCHED; PG8_LDA(At, 1, 0); PG8_STAGE(PG8_SA(0, 1), a2 + hstep, voffA);
            PG8_WAIT_V(8); PG8_WAIT_L(0); PG8_BAR; PG8_MMA(0, 0, At, B0); PG8_MMA(0, 1, At, B1); PG8_BAR; PG8_SCHED;
            PG8_LDA(At, 1, 1); PG8_STAGE(PG8_SB(1, 0), b3, voffB); PG8_STAGE(PG8_SB(1, 1), b3 + hstep, voffB); PG8_STAGE(PG8_SA(1, 0), a3, voffA);
            PG8_WAIT_V(8); PG8_WAIT_L(0); PG8_BAR; PG8_MMA(1, 0, At, B0); PG8_MMA(1, 1, At, B1); PG8_BAR; PG8_SCHED;
            } else {
            PG8_LDB(B0, 0, 0); PG8_SCHED; PG8_LDA(At, 0, 0); PG8_STAGE(PG8_SA(1, 1), a1 + hstep, voffA);
            PG8_WAIT_L(8); PG8_BAR; PG8_WAIT_L(0); PG8_MMA(0, 0, At, B0); PG8_BAR; PG8_SCHED;
            PG8_LDB(B1, 0, 1); PG8_STAGE(PG8_SB(0, 0), b2, voffB);
            PG8_BAR; PG8_WAIT_L(0); PG8_MMA(0, 1, At, B1); PG8_BAR;
            PG8_LDA(At, 0, 1); PG8_STAGE(PG8_SA(0, 0), a2, voffA);
            PG8_BAR; PG8_WAIT_L(0); PG8_MMA(1, 0, At, B0); PG8_BAR; PG8_SCHED;
            PG8_STAGE(PG8_SB(0, 1), b2 + hstep, voffB);
            PG8_WAIT_V(6); PG8_BAR; PG8_MMA(1, 1, At, B1); PG8_BAR;
            PG8_LDB(B0, 1, 0); PG8_SCHED; PG8_LDA(At, 1, 0); PG8_STAGE(PG8_SA(0, 1), a2 + hstep, voffA);
            PG8_WAIT_L(8); PG8_BAR; PG8_WAIT_L(0); PG8_MMA(0, 0, At, B0); PG8_BAR; PG8_SCHED;
            PG8_LDB(B1, 1, 1); PG8_STAGE(PG8_SB(1, 0), b3, voffB);
            PG8_BAR; PG8_WAIT_L(0); PG8_MMA(0, 1, At, B1); PG8_BAR;
            PG8_LDA(At, 1, 1); PG8_STAGE(PG8_SA(1, 0), a3, voffA);
            PG8_BAR; PG8_WAIT_L(0); PG8_MMA(1, 0, At, B0); PG8_BAR; PG8_SCHED;
            PG8_STAGE(PG8_SB(1, 1), b3 + hstep, voffB);
            PG8_WAIT_V(6); PG8_BAR; PG8_MMA(1, 1, At, B1); PG8_BAR;
            }
        }
        if constexpr (ALIGN_EPI) { if (wr == 0) PG8_BAR; }
        if constexpr (!Epi::AFTER_DRAIN) { E(acc, cur, wr, wc, fr, fq); S.done(cur); }
        if (!has_next) break;
#pragma unroll
        for (int a = 0; a < 2; ++a)
#pragma unroll
            for (int b = 0; b < 2; ++b)
#pragma unroll
                for (int m = 0; m < 4; ++m)
#pragma unroll
                    for (int n = 0; n < 2; ++n) acc[a][b][m][n] = (f32x4){0.f, 0.f, 0.f, 0.f};
        cur = nxt; cA = nA; cB = nB; ++ui;
        if constexpr (ALIGN_EPI) { if (wr == 1) PG8_BAR; }
    }
    PG8_WAIT_V(0);
    if constexpr (!ALIGN_EPI) { if (wr == 0) PG8_BAR; }
    PG8_BAR;
    if constexpr (Epi::AFTER_DRAIN) { E.fused(acc, cur, wr, wc, fr, fq, lds, wid, lane); S.done(cur); }
#undef PG8_SA
#undef PG8_SB
#undef PG8_STAGE
#undef PG8_LDA
#undef PG8_LDB
#undef PG8_MMA
#undef PG8_WAIT_V
#undef PG8_WAIT_L
#undef PG8_BAR
#undef PG8_SCHED
}
}

#define GAS __attribute__((address_space(1)))
#define LAS __attribute__((address_space(3)))
typedef unsigned short bf16;
typedef unsigned v4u __attribute__((ext_vector_type(4)));
typedef float f32x4 __attribute__((ext_vector_type(4)));
typedef short bf16x8 __attribute__((ext_vector_type(8)));
typedef GAS unsigned gu32;
typedef GAS unsigned long long gu64;
#define RLX_AGENT __ATOMIC_RELAXED, __HIP_MEMORY_SCOPE_AGENT
#define LDS_WAIT() asm volatile("s_waitcnt lgkmcnt(0)" ::: "memory")
#define VM_WAIT() asm volatile("s_waitcnt vmcnt(0)" ::: "memory")
__device__ __forceinline__ unsigned long long rt() { return __builtin_amdgcn_s_memrealtime(); }
__device__ __forceinline__ unsigned pk2(float lo, float hi) { return (unsigned)f2bf(lo) | ((unsigned)f2bf(hi) << 16); }

#define XB_TMO      128
#define XB_XCNT(j)  (256  + 64 * (j))
#define XB_XSUB(j)  (1280 + 64 * (j))
#define XB_XGEN(j)  (2304 + 64 * (j))
#define XB_TOP      3328
#define XB_TOPGEN   3392
#define XCD_BAR_WORDS 3456
#define XB_SPIN_CAP (1u << 18)

__device__ __forceinline__ unsigned xb_ld(unsigned* p)              { return __hip_atomic_load(p, __ATOMIC_RELAXED, __HIP_MEMORY_SCOPE_AGENT); }
__device__ __forceinline__ unsigned xb_add(unsigned* p, unsigned v) { return __hip_atomic_fetch_add(p, v, __ATOMIC_RELAXED, __HIP_MEMORY_SCOPE_AGENT); }
__device__ __forceinline__ unsigned xb_xcc_id() { return (unsigned)__builtin_amdgcn_s_getreg((3 << 11) | 20) & 0xFu; }
#define XB_SPIN(cond, bar) do { unsigned _sp = 0; while (cond) { __builtin_amdgcn_s_sleep(1); \
    if ((++_sp & 255u) == 0u) { if (xb_ld(&(bar)[XB_TMO])) break; if (_sp > XB_SPIN_CAP) { atomicAdd(&(bar)[XB_TMO], 1u); break; } } } } while (0)

struct XcdBarrier {
    unsigned* bar; unsigned x;
    volatile LAS unsigned* st;
};

__device__ __forceinline__ XcdBarrier xcd_barrier_post(unsigned* bar, volatile LAS unsigned* st) {
    XcdBarrier b; b.bar = bar; b.x = xb_xcc_id(); b.st = st;
    if (threadIdx.x == 0) (void)xb_add(&bar[XB_XCNT(b.x)], 1u);
    return b;
}
__device__ __forceinline__ void xcd_barrier_complete(unsigned* bar, unsigned x, unsigned& nloc, unsigned& nx) {
    const unsigned G = gridDim.x * gridDim.y * gridDim.z;
    unsigned sum, cnt, mine, sp = 0u;
    for (;;) {
        sum = 0u; cnt = 0u; mine = 0u;
#pragma unroll
        for (unsigned j = 0; j < 16; ++j) { const unsigned c = xb_ld(&bar[XB_XCNT(j)]); sum += c; cnt += (c > 0u) ? 1u : 0u; mine = (j == x) ? c : mine; }
        if (sum == G) break;
        __builtin_amdgcn_s_sleep(1);
        if ((++sp & 255u) == 0u) { if (xb_ld(&bar[XB_TMO])) break; if (sp > XB_SPIN_CAP) { atomicAdd(&bar[XB_TMO], 1u); break; } }
    }
    nloc = mine > 0u ? mine : 1u; nx = cnt > 0u ? cnt : 1u;
}

__device__ __forceinline__ void xcd_barrier(const XcdBarrier& b) {
    asm volatile("s_waitcnt vmcnt(0)" ::: "memory");
    __syncthreads();
    if (threadIdx.x == 0) {
        unsigned* bar = b.bar;
        __builtin_amdgcn_s_waitcnt(0);
        unsigned nloc = b.st[0], nx = b.st[1];
        if (nloc == 0u) { xcd_barrier_complete(bar, b.x, nloc, nx); b.st[0] = nloc; b.st[1] = nx; }
        const unsigned old = xb_add(&bar[XB_XSUB(b.x)], 1u);
        const unsigned gen = old / nloc;
        if (old + 1u == (gen + 1u) * nloc) {
            __builtin_amdgcn_fence(__ATOMIC_RELEASE, "agent");
            asm volatile("s_waitcnt vmcnt(0)" ::: "memory");
            const unsigned og = xb_add(&bar[XB_TOP], 1u);
            const unsigned tg = og / nx;
            if (og + 1u == (tg + 1u) * nx) xb_add(&bar[XB_TOPGEN], 1u);
            else XB_SPIN(xb_ld(&bar[XB_TOPGEN]) == tg, bar);
            __builtin_amdgcn_fence(__ATOMIC_ACQUIRE, "agent");
            xb_add(&bar[XB_XGEN(b.x)], 1u);
            asm volatile("s_waitcnt vmcnt(0)" ::: "memory");
        } else {
            XB_SPIN(xb_ld(&bar[XB_XGEN(b.x)]) == gen, bar);
            __builtin_amdgcn_fence(__ATOMIC_ACQUIRE, "agent");
            asm volatile("s_waitcnt vmcnt(0)" ::: "memory");
        }
    }
    __syncthreads();
}

constexpr int NWAVES = 8;
constexpr int RING_OFF = 0, RING_BYTES = 131072;
constexpr int LDSCTL_OFF = RING_BYTES, MISC_OFF = LDSCTL_OFF + 320;
constexpr int LDS_BYTES = 147456;
static_assert(MISC_OFF + 128 <= LDS_BYTES, "LDS map");

struct Frame {
    LAS unsigned char* lds;
    volatile LAS unsigned* MISC;
    gu32* ctl;
    int tid, lane, wave;
    int vcu, G;
};

__device__ const double REV_FREQ[32] = {
    0.15915494309189535, 0.11934937021124886, 0.089499401608891013, 0.067115083005227255, 0.050329212104487035, 0.037741584717419771, 0.028302195830623399, 0.02122365276477766,
    0.015915494309189534, 0.011934937021124886, 0.0089499401608891024, 0.0067115083005227253, 0.0050329212104487037, 0.0037741584717419772, 0.0028302195830623399, 0.0021223652764777662,
    0.0015915494309189536, 0.0011934937021124885, 0.00089499401608891024, 0.0006711508300522726, 0.00050329212104487033, 0.00037741584717419774, 0.00028302195830623395, 0.00021223652764777661,
    0.00015915494309189535, 0.00011934937021124886, 8.9499401608891018e-05, 6.7115083005227254e-05, 5.0329212104487035e-05, 3.7741584717419777e-05, 2.8302195830623396e-05, 2.1223652764777659e-05};
template <bool PERMROWS>
__device__ __forceinline__ void p0_transpose_item(const float* W, int K, int N, bf16* WT, const float* kscale, LAS float* scr, int item, int lane) {
    const int nblk = N / 32, kb = item / nblk, nb = item % nblk, k0 = 64 * kb, n0 = 32 * nb;
    float w[32];
#pragma unroll
    for (int i = 0; i < 32; ++i) { const int kk = 2 * i + (lane >> 5); w[i] = W[(size_t)(k0 + kk) * N + n0 + (lane & 31)]; }
    if (kscale) {
#pragma unroll
        for (int i = 0; i < 32; ++i) w[i] *= kscale[k0 + 2 * i + (lane >> 5)];
    }
#pragma unroll
    for (int i = 0; i < 32; ++i) scr[(2 * i + (lane >> 5)) * 33 + (lane & 31)] = w[i];
    LDS_WAIT(); asm volatile("" ::: "memory");
    const int r0 = PERMROWS ? ((int)(SLOTWC_OF_BLK[n0 >> 6] >> 2) * 256 + (((n0 >> 5) & 1) << 7) + ((int)(SLOTWC_OF_BLK[n0 >> 6] & 3) << 5)) : n0;
    const int c = lane & 7;
#pragma unroll
    for (int j = 0; j < 4; ++j) { const int n = (lane >> 3) + 8 * j; const LAS float* s = scr + (8 * c) * 33 + n;
        v4u o; o.x = pk2(s[0 * 33], s[1 * 33]); o.y = pk2(s[2 * 33], s[3 * 33]); o.z = pk2(s[4 * 33], s[5 * 33]); o.w = pk2(s[6 * 33], s[7 * 33]);
        *(GAS v4u*)(WT + (size_t)(r0 + n) * K + k0 + 8 * c) = o; }
    LDS_WAIT(); asm volatile("" ::: "memory");
}
__device__ __forceinline__ float wave_sum(float v) {
#pragma unroll
    for (int o = 1; o < 64; o <<= 1) v += __shfl_xor(v, o);
    return v;
}

struct Args { const float* in[9]; float* out; unsigned char* ws; int ph_lo, ph_hi, li, pad; float lg2g[4]; float g128[4]; };

struct P0Item { bool has0, is1; int k0, n0; };
__device__ __forceinline__ void p0_tables_and_item(unsigned char* ws, const float* rel_bias, const float* qnw, const float* knw, const float* norm_w, LAS float* scr, int gw, int NGW, int lane, const P0Item& I, float (&w)[32]) {
    Tabs tb = tabs_of(ws);
    for (int i0 = gw * 64; i0 < SH * WIN + 9; i0 += NGW * 64) {
        float mq = fabsf(qnw[lane]), mk = fabsf(knw[lane]);
#pragma unroll
        for (int o = 1; o < 64; o <<= 1) { mq = fmaxf(mq, __shfl_xor(mq, o)); mk = fmaxf(mk, __shfl_xor(mk, o)); }
        const float A = 8.0f * mq * mk * 1.4426950408889634f;
        const int i = i0 + lane;
        const int hsel = (i < SH * WIN) ? (i >> 7) : (i - SH * WIN);
        float Msel = 0.f; bool ok = true;
#pragma unroll
        for (int hq = 0; hq < SH; ++hq) {
            const float v = rel_bias[(lane & 31) * SH + hq] * 1.4426950408889634f;
            float bmax = v, bmin = v;
#pragma unroll
            for (int o = 1; o < 32; o <<= 1) { bmax = fmaxf(bmax, __shfl_xor(bmax, o)); bmin = fminf(bmin, __shfl_xor(bmin, o)); }
            if (hsel == hq) Msel = A + bmax;
            ok = ok && (2.0f * A + (bmax - bmin) < 100.0f);
        }
        if (i < SH * WIN) {
            const int hq = i >> 7, dist = i & 127;
            int bucket;
            if (dist < 16) bucket = dist;
            else { const float nf = (float)dist; int large = 16 + (int)(logf(nf / 16.0f) / 2.0794415416798357f * 16.0f); bucket = large < 31 ? large : 31; }
            tb.biasT[i] = rel_bias[bucket * SH + hq] * 1.4426950408889634f - Msel;
        } else if (i < SH * WIN + SH) tb.biasT[i] = Msel;
        else if (i == SH * WIN + SH) tb.biasT[i] = ok ? 1.0f : 0.0f;
    }
    if (I.has0) {
        if (I.is1) {
#pragma unroll
            for (int i = 0; i < 32; ++i) w[i] *= norm_w[I.k0 + 2 * i + (lane >> 5)];
        }
#pragma unroll
        for (int i = 0; i < 32; ++i) scr[(2 * i + (lane >> 5)) * 33 + (lane & 31)] = w[i];
        LDS_WAIT(); asm volatile("" ::: "memory");
        const int n0 = I.n0;
        const int r0 = I.is1 ? ((int)(SLOTWC_OF_BLK[n0 >> 6] >> 2) * 256 + (((n0 >> 5) & 1) << 7) + ((int)(SLOTWC_OF_BLK[n0 >> 6] & 3) << 5)) : n0;
        bf16* WT = (bf16*)(ws + (I.is1 ? WS_W1 : WS_W2));
        const int c = lane & 7;
#pragma unroll
        for (int j = 0; j < 4; ++j) { const int n = (lane >> 3) + 8 * j; const LAS float* sp = scr + (8 * c) * 33 + n;
            v4u o; o.x = pk2(sp[0 * 33], sp[1 * 33]); o.y = pk2(sp[2 * 33], sp[3 * 33]); o.z = pk2(sp[4 * 33], sp[5 * 33]); o.w = pk2(sp[6 * 33], sp[7 * 33]);
            *(GAS v4u*)(WT + (size_t)(r0 + n) * DM + I.k0 + 8 * c) = o; }
        LDS_WAIT(); asm volatile("" ::: "memory");
    }
}
__device__ __forceinline__ void p0_row(const float* x, float* rstd, bf16* xb, int m, int lane) {
    const GAS f32x4* xr = (const GAS f32x4*)(x + (size_t)m * DM) + lane;
    f32x4 v[4]; float sq = 0.f;
#pragma unroll
    for (int j = 0; j < 4; ++j) { v[j] = __builtin_nontemporal_load(xr + 64 * j); sq += (v[j].x * v[j].x + v[j].y * v[j].y) + (v[j].z * v[j].z + v[j].w * v[j].w); }
    sq = wave_sum(sq);
    if (lane == 0) rstd[m] = 1.0f / sqrtf(sq * (1.0f / DM) + NORM_EPS);
    GAS unsigned long long* o8 = (GAS unsigned long long*)(xb + (size_t)m * DM) + lane;
#pragma unroll
    for (int j = 0; j < 4; ++j) o8[64 * j] = (unsigned long long)pk2(v[j].x, v[j].y) | ((unsigned long long)pk2(v[j].z, v[j].w) << 32);
}
__device__ __forceinline__ void p0_prologue(Frame& F, const Args& args) {
    unsigned char* ws = args.ws;
    const float* x = args.in[0]; const float* norm_w = args.in[1]; const float* w_in = args.in[2]; const float* rel_bias = args.in[7]; const float* w_out = args.in[8];
    LAS float* scr = (LAS float*)(F.lds + RING_OFF + F.wave * 16384);
    const int gw = F.vcu * NWAVES + F.wave, NGW = F.G * NWAVES, lane = F.lane;
    float* rstd = (float*)(ws + WS_RSTD); bf16* xb = (bf16*)(ws + WS_XB);
    static_assert(DM == DMIX, "weight copies share the row pitch");
    constexpr int I_1 = (DM / 64) * (DIN / 32), I_2 = (DMIX / 64) * (DM / 32);
    P0Item I; I.has0 = gw < I_1 + I_2; I.is1 = gw < I_1;
    const float* W = I.is1 ? w_in : w_out; const int N = I.is1 ? DIN : DM; const int item = I.is1 ? gw : gw - I_1;
    { const int nblk = N / 32; I.k0 = 64 * (item / nblk); I.n0 = 32 * (item % nblk); }
    float w[32];
#pragma unroll
    for (int i = 0; i < 32; ++i) w[i] = 0.f;
    if (I.has0) {
#pragma unroll
        for (int i = 0; i < 32; ++i) w[i] = __builtin_nontemporal_load(W + (size_t)(I.k0 + 2 * i + (lane >> 5)) * N + I.n0 + (lane & 31));
    }
    bool did = false;
    int m0 = gw;
    for (; m0 + 7 * NGW < T; m0 += 8 * NGW) {
        f32x4 v[8][4];
#pragma unroll
        for (int r = 0; r < 8; ++r) { const GAS f32x4* xr = (const GAS f32x4*)(x + (size_t)(m0 + r * NGW) * DM) + lane;
#pragma unroll
            for (int j = 0; j < 4; ++j) v[r][j] = __builtin_nontemporal_load(xr + 64 * j); }
        if (!did) { p0_tables_and_item(ws, rel_bias, args.in[4], args.in[5], norm_w, scr, gw, NGW, lane, I, w); did = true; }
#pragma unroll
        for (int r = 0; r < 8; ++r) {
            float sq = 0.f;
#pragma unroll
            for (int j = 0; j < 4; ++j) sq += (v[r][j].x * v[r][j].x + v[r][j].y * v[r][j].y) + (v[r][j].z * v[r][j].z + v[r][j].w * v[r][j].w);
            sq = wave_sum(sq);
            if (lane == 0) rstd[m0 + r * NGW] = 1.0f / sqrtf(sq * (1.0f / DM) + NORM_EPS);
            GAS unsigned long long* o8 = (GAS unsigned long long*)(xb + (size_t)(m0 + r * NGW) * DM) + lane;
#pragma unroll
            for (int j = 0; j < 4; ++j) o8[64 * j] = (unsigned long long)pk2(v[r][j].x, v[r][j].y) | ((unsigned long long)pk2(v[r][j].z, v[r][j].w) << 32);
        }
    }
    if (!did) p0_tables_and_item(ws, rel_bias, args.in[4], args.in[5], norm_w, scr, gw, NGW, lane, I, w);
    for (; m0 < T; m0 += NGW) p0_row(x, rstd, xb, m0, lane);
    for (int it = gw + NGW; it < I_1 + I_2; it += NGW) {
        if (it < I_1) p0_transpose_item<true>(w_in, DM, DIN, (bf16*)(ws + WS_W1), norm_w, scr, it, lane);
        else p0_transpose_item<false>(w_out, DMIX, DM, (bf16*)(ws + WS_W2), nullptr, scr, it - I_1, lane);
    }
}

namespace mid {
typedef short bf16x8 __attribute__((ext_vector_type(8)));
typedef short s16x4 __attribute__((ext_vector_type(4)));
typedef short v4i16_t __attribute__((ext_vector_type(4)));
typedef float f32x16 __attribute__((ext_vector_type(16)));
typedef float f32x2_t __attribute__((ext_vector_type(2)));
typedef __bf16 bf16x2_t __attribute__((ext_vector_type(2)));
#define MDI __device__ __forceinline__
MDI f32x16 mfma32(bf16x8 a, bf16x8 b, f32x16 c) { return __builtin_amdgcn_mfma_f32_32x32x16_bf16(a, b, c, 0, 0, 0); }
MDI int crow(int r, int hi) { return (r & 3) + 8 * (r >> 2) + 4 * hi; }
MDI unsigned cvtpk(float lo, float hi) { f32x2_t v = {lo, hi}; bf16x2_t b = __builtin_convertvector(v, bf16x2_t); return __builtin_bit_cast(unsigned, b); }
MDI bf16x8 pack8(const f32x16& x, int s) { v4u p; p.x = cvtpk(x[8 * s], x[8 * s + 1]); p.y = cvtpk(x[8 * s + 2], x[8 * s + 3]); p.z = cvtpk(x[8 * s + 4], x[8 * s + 5]); p.w = cvtpk(x[8 * s + 6], x[8 * s + 7]); return __builtin_bit_cast(bf16x8, p); }
MDI s16x4 vtr(LAS const unsigned char* p) { return __builtin_bit_cast(s16x4, __builtin_amdgcn_ds_read_tr16_b64_v4i16((LAS v4i16_t*)p)); }
MDI bf16x8 tr8(LAS const unsigned char* p, int off2) { const s16x4 lo = vtr(p), hi = vtr(p + off2); return (bf16x8){lo[0], lo[1], lo[2], lo[3], hi[0], hi[1], hi[2], hi[3]}; }
MDI float lo_bf(unsigned w) { return __uint_as_float(w << 16); }
MDI float hi_bf(unsigned w) { return __uint_as_float(w & 0xffff0000u); }
MDI int timg(int row, int ch  , int bstride) { return (ch >> 2) * bstride + (row >> 4) * 1024 + (row & 15) * 64 + (ch & 3) * 16; }

constexpr int SW_K = 0, SW_V = 32768, SW_B = 65536, SW_S = 69632;
MDI void swa_loadkv(v4u (&kv)[4], v4u (&vv)[4], const bf16* P, int b, int n, int hkv, int tid) {
    const char* base = (const char*)(P + ((long)b * SEQ + (long)(n - 1) * CH) * DIN + O_SK + hkv * 64);
#pragma unroll
    for (int i = 0; i < 4; ++i) {
        const int id = tid + 512 * i, row = id >> 3, ch = id & 7;
        const unsigned off = (unsigned)row * (unsigned)(DIN * 2) + (unsigned)ch * 16u;
        kv[i] = (v4u){0u, 0u, 0u, 0u}; vv[i] = (v4u){0u, 0u, 0u, 0u};
        if (n > 0 || row >= CH) { kv[i] = *(const v4u*)(base + off); vv[i] = *(const v4u*)(base + off + (O_SV - O_SK) * 2); }
    }
}
#define SWA_SB() __builtin_amdgcn_sched_barrier(0)
MDI void swa_units(LAS unsigned char* lds, const bf16* P, bf16* mixed, const float* biasT, const float* sinks, int b, int su0, int nunits, int sb_begin, int sb_end, int tid, int lane, int wave) {
    const int r32 = lane & 31, hi = lane >> 5;
    const int g = wave >> 1, half = wave & 1;
    const int lanepart = r32 - 4 * hi;
    const LAS float* bl = (const LAS float*)(lds + SW_B) + g * 192 + 31 - lanepart;
    const LAS float* bdead = (const LAS float*)(lds + SW_B) + 4 * 192 + 31 - lanepart;
    const int troff = (4 * hi + ((lane & 15) >> 2)) * 64 + ((lane >> 4) & 1) * 32 + (lane & 3) * 8;
#pragma unroll 1
    for (int k = 0; k < nunits; ++k) {
        const int su = su0 + k, n = su >> 1, hkv = su & 1, hq = hkv * 4 + g;
        {
            v4u kv[4], vv[4];
            swa_loadkv(kv, vv, P, b, n, hkv, tid);
            { LAS float* bt = (LAS float*)(lds + SW_B); const int gg = tid >> 7, dd = tid & 127;
              bt[gg * 192 + 159 - dd] = biasT[hkv * 4 * WIN + tid];
              if (tid < 256) bt[(tid >> 6) * 192 + ((tid & 32) ? 160 : 0) + (tid & 31)] = -1e30f;
              if (tid < 192) bt[4 * 192 + tid] = -1e30f; }
#pragma unroll
            for (int i = 0; i < 4; ++i) {
                const int id = tid + 512 * i, row = id >> 3, ch = id & 7;
                *(LAS v4u*)(lds + SW_K + row * 128 + ((ch ^ ((row >> 1) & 7)) << 4)) = kv[i];
                *(LAS v4u*)(lds + SW_V + timg(row, ch, 16384)) = vv[i];
            }
        }
        const float sink = sinks[hq] * 1.4426950408889634f - biasT[SH * WIN + hq];
        const bool fixed_shift = biasT[SH * WIN + SH] != 0.f;
        const size_t trow0 = (size_t)b * SEQ + n * CH + 64 * half;
        bf16x8 qf[4];
#pragma unroll
        for (int s = 0; s < 4; ++s) qf[s] = *(const bf16x8*)(P + (trow0 + 32 * sb_begin + r32) * DIN + O_SQ + hq * 64 + s * 16 + hi * 8);
        __syncthreads();
#pragma unroll 1
        for (int sb = sb_begin; sb < sb_end; ++sb) {
            const int q0 = 64 * half + 32 * sb, jt0 = q0 >> 5;
            f32x16 S[5]; bf16x8 kfr[5][4];
#pragma unroll
            for (int lt = 0; lt < 5; ++lt) {
                const LAS float* bp = (n == 0 && jt0 + lt < 4) ? bdead : bl;
#pragma unroll
                for (int r = 0; r < 16; ++r) S[lt][r] = bp[32 * lt + (r & 3) + 8 * (r >> 2)];
            }
#pragma unroll
            for (int lt = 0; lt < 5; ++lt) {
                const int row = 32 * (jt0 + lt) + r32;
#pragma unroll
                for (int s = 0; s < 4; ++s) { const int c = 2 * s + hi; kfr[lt][s] = *(const LAS bf16x8*)(lds + SW_K + row * 128 + ((c ^ ((row >> 1) & 7)) << 4)); }
            }
            SWA_SB();
#pragma unroll
            for (int s = 0; s < 4; ++s)
#pragma unroll
                for (int lt = 0; lt < 5; ++lt) S[lt] = mfma32(kfr[lt][s], qf[s], S[lt]);
            SWA_SB();
            v4u gt[4];
#pragma unroll
            for (int i = 0; i < 4; ++i) gt[i] = *(const v4u*)(P + (trow0 + 32 * sb + i * 8 + (lane >> 3)) * DIN + O_SG + hq * 64 + (lane & 7) * 8);
            bf16x8 qn[4];
            if (sb + 1 < sb_end) {
#pragma unroll
                for (int s = 0; s < 4; ++s) qn[s] = *(const bf16x8*)(P + (trow0 + 32 * (sb + 1) + r32) * DIN + O_SQ + hq * 64 + s * 16 + hi * 8);
            } else {
#pragma unroll
                for (int s = 0; s < 4; ++s) qn[s] = qf[s];
            }
            float sk = sink;
            if (!fixed_shift) {
                float m = sink;
#pragma unroll
                for (int lt = 0; lt < 5; ++lt)
#pragma unroll
                    for (int r = 0; r < 16; ++r) m = fmaxf(m, S[lt][r]);
                m = fmaxf(m, __shfl_xor(m, 32));
#pragma unroll
                for (int lt = 0; lt < 5; ++lt)
#pragma unroll
                    for (int r = 0; r < 16; ++r) S[lt][r] -= m;
                sk = sink - m;
            }
            float l4[4] = {0.f, 0.f, 0.f, 0.f};
            bf16x8 pa[5][2];
#pragma unroll
            for (int lt = 0; lt < 5; ++lt) {
#pragma unroll
                for (int r = 0; r < 16; ++r) { const float p = __builtin_amdgcn_exp2f(S[lt][r]); S[lt][r] = p; l4[r & 3] += p; }
                pa[lt][0] = pack8(S[lt], 0); pa[lt][1] = pack8(S[lt], 1);
            }
            float l = (l4[0] + l4[1]) + (l4[2] + l4[3]);
            l += __shfl_xor(l, 32); l += __builtin_amdgcn_exp2f(sk);
            const float linv = __builtin_amdgcn_rcpf(l);
            LAS float* wl = (LAS float*)(lds + SW_S + 8 * 4096) + wave * 32;
            if (hi == 0) wl[r32] = linv;
            f32x16 o[2];
#pragma unroll
            for (int d0 = 0; d0 < 2; ++d0) {
                bf16x8 vf[10];
#pragma unroll
                for (int i = 0; i < 10; ++i) vf[i] = tr8(lds + SW_V + d0 * 16384 + (2 * jt0 + i) * 1024 + troff, 512);
                SWA_SB();
                f32x16 oa = {}, ob = {};
#pragma unroll
                for (int lt = 0; lt < 5; ++lt) { oa = mfma32(pa[lt][0], vf[2 * lt], oa); ob = mfma32(pa[lt][1], vf[2 * lt + 1], ob); }
                o[d0] = oa + ob;
                SWA_SB();
            }
            LAS bf16* stg = (LAS bf16*)(lds + SW_S + wave * 4096);
            LDS_WAIT();
#pragma unroll
            for (int r = 0; r < 16; ++r) { const float li = wl[4 * hi + (r & 3) + 8 * (r >> 2)];
#pragma unroll
                for (int d0 = 0; d0 < 2; ++d0) stg[(4 * hi + (r & 3) + 8 * (r >> 2)) * 64 + d0 * 32 + r32] = (bf16)cvtpk(o[d0][r] * li, 0.f); }
            LDS_WAIT();
#pragma unroll
            for (int i = 0; i < 4; ++i) {
                const int row = i * 8 + (lane >> 3), ch = lane & 7;
                const v4u ov = *(const LAS v4u*)(stg + row * 64 + ch * 8);
                const size_t t = (size_t)b * SEQ + n * CH + q0 + row;
                const v4u gv = gt[i];
                v4u res;
                res.x = cvtpk(lo_bf(ov.x) * lo_bf(gv.x), hi_bf(ov.x) * hi_bf(gv.x)); res.y = cvtpk(lo_bf(ov.y) * lo_bf(gv.y), hi_bf(ov.y) * hi_bf(gv.y));
                res.z = cvtpk(lo_bf(ov.z) * lo_bf(gv.z), hi_bf(ov.z) * hi_bf(gv.z)); res.w = cvtpk(lo_bf(ov.w) * lo_bf(gv.w), hi_bf(ov.w) * hi_bf(gv.w));
                *(v4u*)(mixed + t * DMIX + 512 + hq * 64 + ch * 8) = res;
            }
            LDS_WAIT();
#pragma unroll
            for (int s = 0; s < 4; ++s) qf[s] = qn[s];
        }
        __syncthreads();
    }
}

constexpr int PF_BUF = 32768;
#define PF_LOAD(KR, VR, NN) do { _Pragma("unroll") for (int i_ = 0; i_ < 2; ++i_) { const int id_ = tid + 512 * i_, j_ = id_ >> 3, ch_ = id_ & 7; const bf16* src_ = P + (tb + (size_t)(NN) * CH + j_) * DIN; \
        KR[i_] = *(const v4u*)(src_ + O_RK + h * 64 + ch_ * 8); VR[i_] = *(const v4u*)(src_ + O_RV + h * 128 + eh * 64 + ch_ * 8); } } while (0)
#define PF_STEP(KR, VR, NN) do { \
        LAS unsigned char* buf = lds + ((NN) & 1) * PF_BUF; \
        _Pragma("unroll") for (int i_ = 0; i_ < 2; ++i_) { const int id_ = tid + 512 * i_, j_ = id_ >> 3, ch_ = id_ & 7; \
            *(LAS v4u*)(buf + timg(j_, ch_, 8192)) = KR[i_]; *(LAS v4u*)(buf + 16384 + timg(j_, ch_, 8192)) = VR[i_]; } \
        if ((NN) + 4 < NCH) PF_LOAD(KR, VR, (NN) + 4); \
        __syncthreads(); \
        if (wave < 4) { \
            bf16* dst = prevT + (size_t)(NN) * 8192 + (size_t)(64 * eh + 32 * eb + r32) * 64 + 32 * db + 4 * hi; \
            _Pragma("unroll") for (int g4 = 0; g4 < 4; ++g4) { \
                const unsigned long long w_ = (unsigned long long)cvtpk(st[4 * g4], st[4 * g4 + 1]) | ((unsigned long long)cvtpk(st[4 * g4 + 2], st[4 * g4 + 3]) << 32); \
                *(unsigned long long*)(dst + 8 * g4) = w_; } \
            bf16x8 ka_[8], va_[8]; \
            _Pragma("unroll") for (int ks = 0; ks < 8; ++ks) { ka_[ks] = tr8(buf + db * 8192 + ks * 1024 + troff, 512); va_[ks] = tr8(buf + 16384 + eb * 8192 + ks * 1024 + troff, 512); } \
            __builtin_amdgcn_sched_barrier(0); \
            f32x16 acc0 = {}, acc1 = {}; \
            _Pragma("unroll") for (int ks = 0; ks < 8; ks += 2) { acc0 = mfma32(ka_[ks], va_[ks], acc0); acc1 = mfma32(ka_[ks + 1], va_[ks + 1], acc1); } \
            st = (st + (acc0 + acc1)) * gC; } } while (0)
MDI void prefix_unit(LAS unsigned char* lds, const bf16* P, bf16* prevT, float gC, int b, int h, int eh, int tid, int lane, int wave) {
    const int r32 = lane & 31, hi = lane >> 5;
    const size_t tb = (size_t)b * SEQ;
    v4u krA[2], vrA[2], krB[2], vrB[2], krC[2], vrC[2], krD[2], vrD[2];
    PF_LOAD(krA, vrA, 0); PF_LOAD(krB, vrB, 1); PF_LOAD(krC, vrC, 2); PF_LOAD(krD, vrD, 3);
    f32x16 st = {};
    const int db = (wave >> 1) & 1, eb = wave & 1;
    const int troff = (4 * hi + ((lane & 15) >> 2)) * 64 + ((lane >> 4) & 1) * 32 + (lane & 3) * 8;
#pragma unroll 1
    for (int n = 0; n < NCH; n += 4) { PF_STEP(krA, vrA, n); PF_STEP(krB, vrB, n + 1); PF_STEP(krC, vrC, n + 2); PF_STEP(krD, vrD, n + 3); }
    __syncthreads();
}

constexpr int KV_K = 0, KV_V = 16384, RT_P = 49152, RT_ST = 73728, RT_STG_STRIDE = 8704;
MDI void ret_unit(LAS unsigned char* lds, const bf16* P, bf16* mixed, const bf16* prevT, const float* ret_norm_w, int b, int h, int n, int tid, int lane, int wave) {
    const int r32 = lane & 31, hi = lane >> 5;
    const size_t t0 = (size_t)b * SEQ + n * CH;
    v4u kreg[2], vreg[4], preg[2];
#pragma unroll
    for (int i = 0; i < 2; ++i) { const int id = tid + 512 * i, j = id >> 3, ch = id & 7; kreg[i] = *(const v4u*)(P + (t0 + j) * DIN + O_RK + h * 64 + ch * 8); preg[i] = *(const v4u*)(prevT + (size_t)j * 64 + ch * 8); }
#pragma unroll
    for (int i = 0; i < 4; ++i) { const int id = tid + 512 * i, j = id >> 4, ch = id & 15; vreg[i] = *(const v4u*)(P + (t0 + j) * DIN + O_RV + h * 128 + ch * 8); }
    const int qb = (wave < 4) ? (wave >> 1) : 3 - ((wave - 4) >> 1), eh = wave & 1;
    bf16x8 qf[4];
#pragma unroll
    for (int s = 0; s < 4; ++s) qf[s] = *(const bf16x8*)(P + (t0 + 32 * qb + r32) * DIN + O_RQ + h * 64 + s * 16 + hi * 8);
#pragma unroll
    for (int i = 0; i < 2; ++i) { const int id = tid + 512 * i, j = id >> 3, ch = id & 7; const int off = j * 128 + ((ch ^ ((j >> 1) & 7)) << 4);
        *(LAS v4u*)(lds + KV_K + off) = kreg[i]; *(LAS v4u*)(lds + RT_P + off) = preg[i]; }
#pragma unroll
    for (int i = 0; i < 4; ++i) { const int id = tid + 512 * i, j = id >> 4, ch = id & 15; *(LAS v4u*)(lds + KV_V + timg(j, ch, 8192)) = vreg[i]; }
    __syncthreads();
    f32x16 o[2]; o[0] = (f32x16){}; o[1] = (f32x16){};
    const int tq = ((lane & 15) >> 2) * 64 + ((lane >> 4) & 1) * 32 + (lane & 3) * 8;
#pragma unroll
    for (int s = 0; s < 4; ++s)
#pragma unroll
        for (int eb = 0; eb < 2; ++eb) { const int row = 32 * (2 * eh + eb) + r32, c = 2 * s + hi;
            const bf16x8 a = *(const LAS bf16x8*)(lds + RT_P + row * 128 + ((c ^ ((row >> 1) & 7)) << 4)); o[eb] = mfma32(a, qf[s], o[eb]); }
#pragma unroll 1
    for (int jt = 0; jt <= qb; ++jt) {
        const int row = 32 * jt + r32;
        f32x16 acc = {};
#pragma unroll
        for (int s = 0; s < 4; ++s) { const int c = 2 * s + hi; const bf16x8 kf = *(const LAS bf16x8*)(lds + KV_K + row * 128 + ((c ^ ((row >> 1) & 7)) << 4)); acc = mfma32(kf, qf[s], acc); }
        if (jt == qb) {
#pragma unroll
            for (int r = 0; r < 16; ++r) acc[r] = (crow(r, hi) > r32) ? 0.f : acc[r];
        }
#pragma unroll
        for (int s2 = 0; s2 < 2; ++s2) {
            const bf16x8 pb = pack8(acc, s2); const int ks = 2 * jt + s2;
#pragma unroll
            for (int eb = 0; eb < 2; ++eb) { const bf16x8 a = tr8(lds + KV_V + (2 * eh + eb) * 8192 + ks * 1024 + 4 * hi * 64 + tq, 512); o[eb] = mfma32(a, pb, o[eb]); }
        }
    }
    float s1 = 0.f;
#pragma unroll
    for (int eb = 0; eb < 2; ++eb)
#pragma unroll
        for (int r = 0; r < 16; ++r) s1 += o[eb][r];
    s1 += __shfl_xor(s1, 32);
    const float mean64 = s1 * (1.0f / 64.0f);
    float m2 = 0.f;
#pragma unroll
    for (int eb = 0; eb < 2; ++eb)
#pragma unroll
        for (int r = 0; r < 16; ++r) { const float dd = o[eb][r] - mean64; m2 += dd * dd; }
    m2 += __shfl_xor(m2, 32);
    LAS f32x2_t* stats = (LAS f32x2_t*)(lds + RT_ST);
    if (hi == 0) stats[(qb * 2 + eh) * 32 + r32] = (f32x2_t){mean64, m2};
    __syncthreads();
    const f32x2_t ot = stats[(qb * 2 + (eh ^ 1)) * 32 + r32];
    const float mean = 0.5f * (mean64 + ot.x), dm = mean64 - ot.x;
    const float var = (m2 + ot.y + 32.0f * dm * dm) * (1.0f / 128.0f);
    const float rstd = 1.0f / sqrtf(var + GN_EPS);
    LAS float* st = (LAS float*)(lds + wave * RT_STG_STRIDE);
#pragma unroll
    for (int eb = 0; eb < 2; ++eb)
#pragma unroll
        for (int g4 = 0; g4 < 4; ++g4) {
            f32x4 v; v[0] = (o[eb][4 * g4 + 0] - mean) * rstd; v[1] = (o[eb][4 * g4 + 1] - mean) * rstd; v[2] = (o[eb][4 * g4 + 2] - mean) * rstd; v[3] = (o[eb][4 * g4 + 3] - mean) * rstd;
            *(LAS f32x4*)(st + r32 * 68 + eb * 32 + 8 * g4 + 4 * hi) = v;
        }
    LDS_WAIT();
    {
        const int ch = lane & 7, e = 64 * eh + ch * 8;
        v4u gv[4];
#pragma unroll
        for (int i = 0; i < 4; ++i) gv[i] = *(const v4u*)(P + (t0 + 32 * qb + i * 8 + (lane >> 3)) * DIN + O_RG + h * 128 + e);
        const f32x4 n0 = *(const f32x4*)(ret_norm_w + h * 128 + e), n1 = *(const f32x4*)(ret_norm_w + h * 128 + e + 4);
#pragma unroll
        for (int i = 0; i < 4; ++i) {
            const int q = i * 8 + (lane >> 3);
            const f32x4 a0 = *(const LAS f32x4*)(st + q * 68 + ch * 8), a1 = *(const LAS f32x4*)(st + q * 68 + ch * 8 + 4);
            const size_t t = t0 + 32 * qb + q;
            v4u res;
            res.x = cvtpk(a0[0] * n0[0] * lo_bf(gv[i].x), a0[1] * n0[1] * hi_bf(gv[i].x)); res.y = cvtpk(a0[2] * n0[2] * lo_bf(gv[i].y), a0[3] * n0[3] * hi_bf(gv[i].y));
            res.z = cvtpk(a1[0] * n1[0] * lo_bf(gv[i].z), a1[1] * n1[1] * hi_bf(gv[i].z)); res.w = cvtpk(a1[2] * n1[2] * lo_bf(gv[i].w), a1[3] * n1[3] * hi_bf(gv[i].w));
            *(v4u*)(mixed + t * DMIX + h * 128 + e) = res;
        }
    }
    LDS_WAIT();
    __syncthreads();
}
}

struct ProjOrder {
    pg8::StaticOrder so; bool single; int pm1, pn1;
    __device__ __forceinline__ bool next(int i, pg8::Unit& u) const { if (!single) return so.next(i, u); if (i > 0) return false; u.pm = pm1; u.pn = pn1; return true; }
    __device__ __forceinline__ void a_ready(const pg8::Unit&) const {}
    __device__ __forceinline__ void done(const pg8::Unit&) const {}
};
constexpr int N_PHASES = 5;
__global__ void __launch_bounds__(NWAVES * 64, 2) skel_fwd(Args args) {
    extern __shared__ __attribute__((aligned(16))) unsigned char lds[];
    Frame F;
    F.lds = (LAS unsigned char*)lds;
    F.MISC = (volatile LAS unsigned*)(F.lds + MISC_OFF);
    F.tid = threadIdx.x; F.lane = F.tid & 63; F.wave = __builtin_amdgcn_readfirstlane(F.tid >> 6);
    F.G = gridDim.x; { const int bx = blockIdx.x; F.vcu = (F.G % 8 == 0) ? (bx % 8) * (F.G / 8) + bx / 8 : bx; }
    unsigned char* ws = args.ws;
    F.ctl = (gu32*)(ws + WS_CTL);
    for (int u = F.tid; u < (LDS_BYTES - LDSCTL_OFF) / 4; u += NWAVES * 64) ((LAS unsigned*)(F.lds + LDSCTL_OFF))[u] = 0u;
    __syncthreads();
    XcdBarrier bar = xcd_barrier_post((unsigned*)(F.ctl + CW_BAR) + args.li * XCD_BAR_WORDS, F.MISC + 8);
    const int lo = args.ph_lo, hi = args.ph_hi;
#define IN(k) (lo <= (k) && (k) < hi)
#define BOTH(k) (IN(k) && IN((k) + 1))

    if (IN(0)) { p0_prologue(F, args); if (BOTH(0)) xcd_barrier(bar); }

    const int grp = F.vcu >> 5, jg = F.vcu & 31;
    const bool map256 = (F.G == 256);
    if (IN(1)) {
        pg8::Gemm g{(const bf16*)(ws + WS_XB), (const bf16*)(ws + WS_W1), T, 8 * 256, DM};
        ProjOrder S; S.so.init(T, 8 * 256, F.G, (int)blockIdx.x); S.single = false; S.pm1 = 0; S.pn1 = 0;
        Tabs tb = tabs_of(ws);
        pg8::EpiProj E{(bf16*)(ws + WS_P), (const float*)(ws + WS_RSTD), args.in[4], args.in[5], args.lg2g[0], args.lg2g[1], args.lg2g[2], args.lg2g[3], 0};
        pg8::gemm_phase<pg8::EpiProj, ProjOrder, true, true>(F.lds + RING_OFF, g, S, E);
        if (BOTH(1)) xcd_barrier(bar);
    }
    if (IN(2)) {
        const bool aux = map256 && (jg >= 24);
        const bf16* Pb = (const bf16*)(ws + WS_P); bf16* mixed = (bf16*)(ws + WS_MIX); Tabs tb = tabs_of(ws);
        if (!aux) {
            pg8::Gemm g{(const bf16*)(ws + WS_XB), (const bf16*)(ws + WS_W1) + (size_t)8 * 256 * DM, T, 3 * 256, DM};
            ProjOrder S; S.so.init(T, 3 * 256, F.G, (int)blockIdx.x); S.single = map256; S.pm1 = grp * 8 + (jg & 7); S.pn1 = jg >> 3;
            pg8::EpiProj E{(bf16*)(ws + WS_P), (const float*)(ws + WS_RSTD), args.in[4], args.in[5], args.lg2g[0], args.lg2g[1], args.lg2g[2], args.lg2g[3], 8};
            pg8::gemm_phase<pg8::EpiProj, ProjOrder, true, true>(F.lds + RING_OFF, g, S, E);
        }
        if (map256) {
            if (aux) {
                const int a8 = jg - 24;
                mid::swa_units(F.lds, Pb, mixed, tb.biasT, args.in[6], grp, a8, 1, 0, 2, F.tid, F.lane, F.wave);
                const int h = a8 >> 1; const float gC = h == 0 ? args.g128[0] : h == 1 ? args.g128[1] : h == 2 ? args.g128[2] : args.g128[3];
                mid::prefix_unit(F.lds, Pb, (bf16*)(ws + WS_PREV) + (size_t)(grp * 4 + h) * NCH * 8192, gC, grp, h, a8 & 1, F.tid, F.lane, F.wave);
            }
        } else {
            for (int u = F.vcu; u < BATCH * NCH * SKV; u += F.G) mid::swa_units(F.lds, Pb, mixed, tb.biasT, args.in[6], u >> 5, u & 31, 1, 0, 2, F.tid, F.lane, F.wave);
            for (int u = F.vcu; u < BATCH * RH * 2; u += F.G) { const int h = (u >> 1) & 3; const float gC = h == 0 ? args.g128[0] : h == 1 ? args.g128[1] : h == 2 ? args.g128[2] : args.g128[3];
                mid::prefix_unit(F.lds, Pb, (bf16*)(ws + WS_PREV) + (size_t)(u >> 1) * NCH * 8192, gC, u >> 3, h, u & 1, F.tid, F.lane, F.wave); }
        }
        if (BOTH(2)) xcd_barrier(bar);
    }

    if (IN(3)) {
        const bf16* Pb = (const bf16*)(ws + WS_P); bf16* mixed = (bf16*)(ws + WS_MIX);
        if (map256) { Tabs tb = tabs_of(ws);
            if (jg < 16) mid::swa_units(F.lds, Pb, mixed, tb.biasT, args.in[6], grp, 8 + jg, 1, 0, 2, F.tid, F.lane, F.wave);
            else mid::swa_units(F.lds, Pb, mixed, tb.biasT, args.in[6], grp, 24 + ((jg - 16) >> 1), 1, jg & 1, (jg & 1) + 1, F.tid, F.lane, F.wave); }
        for (int u = F.vcu; u < BATCH * RH * NCH; u += F.G) {
            const int bh = (u & 255) >> 3, j = u & 7, n = (u < 256) ? j : 15 - j, h = bh & 3, b = bh >> 2;
            mid::ret_unit(F.lds, Pb, mixed, (const bf16*)(ws + WS_PREV) + ((size_t)bh * NCH + n) * 8192, args.in[3], b, h, n, F.tid, F.lane, F.wave);
        }
        if (BOTH(3)) xcd_barrier(bar);
    }

    if (IN(4)) {
        pg8::Gemm g{(const bf16*)(ws + WS_MIX), (const bf16*)(ws + WS_W2), T, DM, DMIX}; pg8::StaticOrder S; S.init(T, DM, F.G, (int)blockIdx.x);
        pg8::EpiRes E{args.in[0], args.out, DM};
        pg8::gemm_phase<pg8::EpiRes, pg8::StaticOrder, true, true>(F.lds + RING_OFF, g, S, E);
    }
#undef IN
#undef BOTH
}

extern "C" void kernel_launch(void* const* d_in, const int* in_sizes, int n_in, void* d_out, int out_size, void* d_ws, size_t ws_size, hipStream_t stream) {
    static int grid = 0;
    if (grid == 0) {
        if (n_in != 9 || in_sizes[0] != T * DM || out_size != T * DM || ws_size < WS_END) { fprintf(stderr, "kernel_launch: unexpected shapes (n_in %d, ws %zu)\n", n_in, ws_size); grid = -1; return; }
        int dev = 0, cus = 0, per_cu = 0;
        if (hipGetDevice(&dev) != hipSuccess || hipDeviceGetAttribute(&cus, hipDeviceAttributeMultiprocessorCount, dev) != hipSuccess) { grid = -1; return; }
        if (hipFuncSetAttribute((const void*)skel_fwd, hipFuncAttributeMaxDynamicSharedMemorySize, LDS_BYTES) != hipSuccess) { fprintf(stderr, "kernel_launch: hipFuncSetAttribute failed\n"); grid = -1; return; }
        if (hipOccupancyMaxActiveBlocksPerMultiprocessor(&per_cu, (const void*)skel_fwd, NWAVES * 64, LDS_BYTES) != hipSuccess || per_cu < 1) { fprintf(stderr, "kernel_launch: occupancy query says %d blocks per CU\n", per_cu); grid = -1; return; }
        (void)hipGetLastError();
        grid = cus * 1;
    }
    if (grid < 0) return;
    (void)hipMemsetAsync((char*)d_ws + WS_CTL, 0, CTL_ZERO_BYTES, stream);
    Args a{};
    for (int i = 0; i < 9; ++i) a.in[i] = (const float*)d_in[i];
    a.out = (float*)d_out; a.ws = (unsigned char*)d_ws;
    for (int h = 0; h < 4; ++h) { const double g = 1.0 - std::exp2(-5.0 - h); a.lg2g[h] = (float)std::log2(g); a.g128[h] = (float)std::pow(g, 128.0); }
    a.ph_lo = 0; a.ph_hi = N_PHASES; a.li = 0;
    hipLaunchKernelGGL(skel_fwd, dim3(grid), dim3(NWAVES * 64), LDS_BYTES, stream, a);
}
```

```cpp
#include <hip/hip_runtime.h>
#include <cstdio>
#include <cstdint>
#include <cmath>

constexpr int DM = 1024, BATCH = 8, SEQ = 2048, T = BATCH * SEQ;
constexpr int RH = 4, RDK = 64, RDV = 128, CH = 128, NCH = SEQ / CH;
constexpr int SH = 8, SKV = 2, SD = 64, SG = 4, WIN = 128;
constexpr int O_RQ = 0, O_RK = 256, O_RV = 512, O_RG = 1024, O_SQ = 1536, O_SK = 2048, O_SV = 2176, O_SG = 2304, DIN = 2816;
#define PXT(tile, row, within) ((((size_t)(tile)) * (size_t)T + (size_t)(row)) * 256 + (size_t)(within))
constexpr int DMIX = 1024;
constexpr float NORM_EPS = 1e-6f, GN_EPS = 1e-5f;

constexpr size_t MiB = 1u << 20;
constexpr size_t WS_CTL = 0, CTL_ZERO_BYTES = 131072;
constexpr size_t WS_TAB = 1 * MiB;
constexpr size_t WS_W1 = 2 * MiB;
constexpr size_t WS_W2 = 8 * MiB;
constexpr size_t WS_RSTD = 10 * MiB;
constexpr size_t WS_PREV = 12 * MiB;
constexpr unsigned long long TILE_OF_SLOT = 0x540321a9876ull;
constexpr unsigned long long SLOT_OF_TILE = 0x43210a97658ull;
constexpr size_t WS_XB = 32 * MiB;
constexpr size_t WS_P = 64 * MiB;
constexpr size_t WS_MIX = 152 * MiB;
constexpr size_t WS_END = 184 * MiB;
constexpr int CW_BAR = 4096;
constexpr int CW_GRP = 8192;
constexpr int CW_X = 16384 + 96 * 64;
constexpr int CW_R3 = 16384;
constexpr int CW_PFX = 16384 + 64 * 64;
constexpr int CW_PAN = 8192 + 64 * 64;
constexpr int CW_XMASK = 8192 + 48 * 64;

typedef unsigned short bf16_t;
__device__ __forceinline__ bf16_t f2bf(float f) { unsigned u = __float_as_uint(f); return (bf16_t)((u + 0x7fffu + ((u >> 16) & 1u)) >> 16); }
__device__ __forceinline__ float bf2f(bf16_t b) { return __uint_as_float(((unsigned)b) << 16); }
__device__ __forceinline__ float silu_f(float v) { return v / (1.f + __expf(-v)); }

struct Tabs { float* cosT; float* sinT; float* biasT; };
__host__ __device__ inline Tabs tabs_of(unsigned char* ws) { Tabs t; t.cosT = (float*)(ws + WS_TAB); t.sinT = t.cosT + SEQ * 32; t.biasT = t.sinT + SEQ * 32; return t; }

namespace pg8 {
#define PG8_LAS __attribute__((address_space(3)))
typedef unsigned short bf16_t;
typedef short bf16x8 __attribute__((ext_vector_type(8)));
typedef float f32x4 __attribute__((ext_vector_type(4)));
typedef unsigned u32x4 __attribute__((ext_vector_type(4)));
constexpr int BM = 256, BK = 64, HALF = 128, HTB = HALF * BK * 2  , STAGE_BYTES = 8 * HTB, NXCD = 8, WGM = 8;

__host__ __device__ __forceinline__ int lds_byte(int r, int c) { const int st = (r >> 4) * 2 + (c >> 5), rr = r & 15, cc = c & 31, ob = rr * 64 + cc * 2; return st * 1024 + (ob ^ (((ob >> 9) & 1) << 5)); }
__host__ __device__ __forceinline__ void stage_rc(int b, int& R, int& C) { const int st = b / 1024, sb = b % 1024, swz = sb ^ (((sb >> 9) & 1) << 5); R = (st >> 1) * 16 + swz / 64; C = (st & 1) * 32 + (swz % 64) / 2; }
__host__ __device__ __forceinline__ int perm32(int rho) { const int n = rho >> 4, i = rho & 15; return 8 * (i >> 2) + 4 * n + (i & 3); }

struct Unit { int pm, pn; };
struct Gemm { const bf16_t* A; const bf16_t* Bt; int M, N, K; };

struct StaticOrder {
    int nM, nN, nwg, G, c;
    __host__ __device__ void init(int M, int N, int G_, int c_) { nM = M / BM; nN = N / BM; nwg = nM * nN; G = G_; c = c_; }
    __host__ __device__ bool next(int i, Unit& u) const {
        const long L = (long)i * G + c; if (L >= nwg) return false;
        int wgid = (int)L; { const int q = nwg / NXCD, r = nwg % NXCD, xcd = wgid % NXCD, off = wgid / NXCD; wgid = (xcd < r ? xcd * (q + 1) : r * (q + 1) + (xcd - r) * q) + off; }
        const int nig = WGM * nN, gid = wgid / nig, fm = gid * WGM, gsz = (nM - fm) < WGM ? (nM - fm) : WGM;
        u.pm = fm + ((wgid % nig) % gsz); u.pn = (wgid % nig) / gsz; return true;
    }
    __device__ __forceinline__ void a_ready(const Unit&) const {}
    __device__ __forceinline__ void done(const Unit&) const {}
};

__device__ __forceinline__ unsigned cvt_pk_bf16(float lo, float hi) { unsigned r; asm volatile("v_cvt_pk_bf16_f32 %0, %1, %2" : "=v"(r) : "v"(lo), "v"(hi)); return r; }
__device__ __forceinline__ float fast_silu(float v) { return v * __builtin_amdgcn_rcpf(1.f + __expf(-v)); }

__device__ const unsigned REVFIX[32] = {
    683565276u, 512601642u, 384397003u, 288257087u, 216162320u, 162098872u, 121557005u, 91154895u, 68356528u, 51260164u, 38439700u, 28825709u, 21616232u, 16209887u, 12155701u, 9115489u,
    6835653u, 5126016u, 3843970u, 2882571u, 2161623u, 1620989u, 1215570u, 911549u, 683565u, 512602u, 384397u, 288257u, 216162u, 162099u, 121557u, 91155u};
struct EpiProj {
    static constexpr bool PERM = true, AFTER_DRAIN = false;
    bf16_t* P; const float* rstd; const float* qnw; const float* knw; float lg2g0, lg2g1, lg2g2, lg2g3; int slot0;
    __device__ __forceinline__ void operator()(const f32x4 (&acc)[2][2][4][2], const Unit& u, int wr, int wc, int fr, int fq) const {
        const int pn = (int)((TILE_OF_SLOT >> (4 * (slot0 + u.pn))) & 15ull);
        const int row0 = u.pm * BM + wr * 64 + fr;
        const int lcol = pn * 256 + wc * 64 + 8 * fq;
        int kind;
        if (pn == 0) kind = 2; else if (pn == 1) kind = 3; else if (pn < 4) kind = 0; else if (pn < 6) kind = 1; else if (pn < 8) kind = 4; else if (pn == 8) kind = (wc < 2) ? 5 : 0; else kind = 1;
        const float lg2g = wc == 0 ? lg2g0 : wc == 1 ? lg2g1 : wc == 2 ? lg2g2 : lg2g3;
        float rs[2][4];
#pragma unroll
        for (int ai = 0; ai < 2; ++ai)
#pragma unroll
            for (int m = 0; m < 4; ++m) rs[ai][m] = rstd[row0 + ai * HALF + m * 16];
        f32x4 nwv[2][2];
#pragma unroll
        for (int bj = 0; bj < 2; ++bj)
#pragma unroll
            for (int n = 0; n < 2; ++n) nwv[bj][n] = (f32x4){1.f, 1.f, 1.f, 1.f};
        u32x4 rfx[2]; rfx[0] = (u32x4){0u, 0u, 0u, 0u}; rfx[1] = rfx[0];
        if (kind == 4 || kind == 5) {
            const float* nw = kind == 4 ? qnw : knw; const float sc = kind == 4 ? 0.125f * 1.4426950408889634f : 1.f;
#pragma unroll
            for (int bj = 0; bj < 2; ++bj)
#pragma unroll
                for (int n = 0; n < 2; ++n) nwv[bj][n] = *(const f32x4*)(nw + 32 * bj + 8 * fq + 4 * n) * sc;
        } else if (kind == 2 || kind == 3) {
            rfx[0] = *(const u32x4*)(REVFIX + 8 * fq); rfx[1] = *(const u32x4*)(REVFIX + 8 * fq + 4);
        }
#pragma unroll
        for (int ai = 0; ai < 2; ++ai)
#pragma unroll
            for (int m = 0; m < 4; ++m) {
                const int r = row0 + ai * HALF + m * 16;
                const float rsv = rs[ai][m];
                f32x4 v[2][2];
#pragma unroll
                for (int bj = 0; bj < 2; ++bj)
#pragma unroll
                    for (int n = 0; n < 2; ++n) v[bj][n] = acc[ai][bj][m][n] * rsv;
                if (kind == 2 || kind == 3) {
                    const unsigned sp = (unsigned)(r & (SEQ - 1)); const int ci = (int)(sp & (CH - 1));
                    const float e = lg2g * (float)(ci + 1);
                    const float sc = kind == 2 ? __builtin_amdgcn_exp2f(e) : 0.125f * __builtin_amdgcn_exp2f(-e);
#pragma unroll
                    for (int n = 0; n < 2; ++n) {
                        f32x4 cs, sn;
#pragma unroll
                        for (int j = 0; j < 4; ++j) { const float rev = (float)(sp * rfx[n][j]) * 2.3283064365386963e-10f; cs[j] = __builtin_amdgcn_cosf(rev); sn[j] = __builtin_amdgcn_sinf(rev); }
                        const f32x4 t1 = v[0][n], t2 = v[1][n];
                        v[0][n] = (t1 * cs - t2 * sn) * sc; v[1][n] = (t1 * sn + t2 * cs) * sc;
                    }
                } else if (kind == 4 || kind == 5) {
                    float ss = 0.f;
#pragma unroll
                    for (int bj = 0; bj < 2; ++bj)
#pragma unroll
                        for (int n = 0; n < 2; ++n) { const f32x4 x = v[bj][n]; ss += (x[0] * x[0] + x[1] * x[1]) + (x[2] * x[2] + x[3] * x[3]); }
                    ss += __shfl_xor(ss, 16); ss += __shfl_xor(ss, 32);
                    const float rn = 1.0f / sqrtf(ss * (1.0f / 64.0f) + NORM_EPS);
#pragma unroll
                    for (int bj = 0; bj < 2; ++bj)
#pragma unroll
                        for (int n = 0; n < 2; ++n) v[bj][n] = v[bj][n] * rn * nwv[bj][n];
                } else if (kind == 1) {
#pragma unroll
                    for (int bj = 0; bj < 2; ++bj)
#pragma unroll
                        for (int n = 0; n < 2; ++n)
#pragma unroll
                            for (int j = 0; j < 4; ++j) v[bj][n][j] = fast_silu(v[bj][n][j]);
                }
                bf16_t* rowp = P + PXT(pn, r, wc * 64 + 8 * fq);
#pragma unroll
                for (int bj = 0; bj < 2; ++bj) {
                    u32x4 w; w.x = cvt_pk_bf16(v[bj][0][0], v[bj][0][1]); w.y = cvt_pk_bf16(v[bj][0][2], v[bj][0][3]); w.z = cvt_pk_bf16(v[bj][1][0], v[bj][1][1]); w.w = cvt_pk_bf16(v[bj][1][2], v[bj][1][3]);
                    *(u32x4*)(rowp + 32 * bj) = w;
                }
            }
    }
};
struct EpiRes {
    static constexpr bool PERM = false, AFTER_DRAIN = false;
    const float* base; float* out; int ldc; int pre_pm, pre_pn;
    __device__ __forceinline__ void operator()(const f32x4 (&acc)[2][2][4][2], const Unit& u, int wr, int wc, int fr, int fq) const {
        const int col0 = u.pn * BM + wc * 32 + 4 * fq;
        if (u.pm == pre_pm && u.pn == pre_pn) {
#pragma unroll
            for (int ai = 0; ai < 2; ++ai)
#pragma unroll
                for (int m = 0; m < 4; ++m) { const size_t off = (size_t)(u.pm * BM + ai * HALF + wr * 64 + m * 16 + fr) * ldc + col0;
#pragma unroll
                    for (int bj = 0; bj < 2; ++bj)
#pragma unroll
                        for (int n = 0; n < 2; ++n) *(f32x4*)(out + off + bj * HALF + n * 16) = acc[ai][bj][m][n]; }
            return;
        }
#pragma unroll
        for (int ai = 0; ai < 2; ++ai) {
            f32x4 bs[4][2][2];
#pragma unroll
            for (int m = 0; m < 4; ++m) { const size_t off = (size_t)(u.pm * BM + ai * HALF + wr * 64 + m * 16 + fr) * ldc + col0;
#pragma unroll
                for (int bj = 0; bj < 2; ++bj)
#pragma unroll
                    for (int n = 0; n < 2; ++n) bs[m][bj][n] = __builtin_nontemporal_load((const f32x4*)(base + off + bj * HALF + n * 16)); }
#pragma unroll
            for (int m = 0; m < 4; ++m) { const size_t off = (size_t)(u.pm * BM + ai * HALF + wr * 64 + m * 16 + fr) * ldc + col0;
#pragma unroll
                for (int bj = 0; bj < 2; ++bj)
#pragma unroll
                    for (int n = 0; n < 2; ++n) *(f32x4*)(out + off + bj * HALF + n * 16) = bs[m][bj][n] + acc[ai][bj][m][n]; }
        }
    }
};

template <class Epi, class Sched, bool ALIGN_EPI = false, bool SP2 = false, bool PRE = false>
__device__ __forceinline__ void gemm_phase(PG8_LAS unsigned char* lds, const Gemm g, const Sched& S, const Epi& E, const f32x4 (&init)[2][2][4][2]) {
    const int tid = threadIdx.x, wid = __builtin_amdgcn_readfirstlane(tid >> 6), lane = tid & 63, wr = wid >> 2, wc = wid & 3, fr = lane & 15, fq = lane >> 4;
    const int K = g.K, nt = K / BK;
    unsigned voffA[2], voffB[2];
#pragma unroll
    for (int i = 0; i < 2; ++i) { int R, C; stage_rc(tid * 16 + i * 8192, R, C); const int Rb = Epi::PERM ? ((R & ~31) + perm32(R & 31)) : R;
        voffA[i] = (unsigned)(R * K + C) * 2u; voffB[i] = (unsigned)(Rb * K + C) * 2u; }
    const size_t kstep = (size_t)(BK * 2);
    const size_t hstep = (size_t)HALF * K * 2;
    const size_t tstep = 2 * hstep;
    const unsigned ldsw = (unsigned)wid * 1024u;
    const int aoff = lds_byte(wr * 64 + fr, fq * 8), boff = lds_byte(wc * 32 + fr, fq * 8);
#define PG8_SA(b, h) (((b) * 2 + (h)) * HTB)
#define PG8_SB(b, h) ((4 + (b) * 2 + (h)) * HTB)
#define PG8_STAGE(bufoff, gbase, voff) do { _Pragma("unroll") for (int _i = 0; _i < 2; ++_i) \
        __builtin_amdgcn_global_load_lds((const unsigned*)((const char*)(gbase) + (voff)[_i]), (PG8_LAS unsigned*)(lds + (bufoff) + ldsw + _i * 8192), 16, 0, 0); } while (0)
#define PG8_LDA(dst, b, h) do { _Pragma("unroll") for (int m = 0; m < 4; ++m) _Pragma("unroll") for (int k = 0; k < 2; ++k) dst[m][k] = *(const PG8_LAS bf16x8*)(lds + PG8_SA(b, h) + aoff + m * 2048 + k * 1024); } while (0)
#define PG8_LDB(dst, b, h) do { _Pragma("unroll") for (int n = 0; n < 2; ++n) _Pragma("unroll") for (int k = 0; k < 2; ++k) dst[n][k] = *(const PG8_LAS bf16x8*)(lds + PG8_SB(b, h) + boff + n * 2048 + k * 1024); } while (0)
#define PG8_MMA(ai, bj, At, Bt) do { __builtin_amdgcn_s_setprio(1); _Pragma("unroll") for (int m = 0; m < 4; ++m) _Pragma("unroll") for (int n = 0; n < 2; ++n) _Pragma("unroll") for (int k = 0; k < 2; ++k) \
        acc[ai][bj][m][n] = __builtin_amdgcn_mfma_f32_16x16x32_bf16(Bt[n][k], At[m][k], acc[ai][bj][m][n], 0, 0, 0); __builtin_amdgcn_s_setprio(0); } while (0)
#define PG8_WAIT_V(n) asm volatile("s_waitcnt vmcnt(" #n ")" ::: "memory")
#define PG8_WAIT_L(n) asm volatile("s_waitcnt lgkmcnt(" #n ")" ::: "memory")
#define PG8_BAR __builtin_amdgcn_s_barrier()
#define PG8_SCHED __builtin_amdgcn_sched_barrier(0)
    Unit cur, nxt; int ui = 0;
    if (!S.next(0, cur)) return;
    f32x4 acc[2][2][4][2];
#pragma unroll
    for (int a = 0; a < 2; ++a)
#pragma unroll
        for (int b = 0; b < 2; ++b)
#pragma unroll
            for (int m = 0; m < 4; ++m)
#pragma unroll
                for (int n = 0; n < 2; ++n) acc[a][b][m][n] = PRE ? init[a][b][m][n] : (f32x4){0.f, 0.f, 0.f, 0.f};
    bf16x8 At[4][2], B0[2][2], B1[2][2];
    const char* cA = (const char*)g.A + (size_t)cur.pm * tstep; const char* cB = (const char*)g.Bt + (size_t)cur.pn * tstep;
    if constexpr (SP2) {
        PG8_STAGE(PG8_SB(0, 0), cB, voffB); PG8_STAGE(PG8_SB(0, 1), cB + hstep, voffB);
        S.a_ready(cur);
        PG8_STAGE(PG8_SA(0, 0), cA, voffA); PG8_STAGE(PG8_SA(0, 1), cA + hstep, voffA);
        if (wr == 1) PG8_BAR;
        PG8_WAIT_V(2); PG8_BAR;
        PG8_STAGE(PG8_SB(1, 0), cB + kstep, voffB); PG8_STAGE(PG8_SA(1, 0), cA + kstep, voffA); PG8_STAGE(PG8_SB(1, 1), cB + hstep + kstep, voffB);
        PG8_WAIT_V(6); PG8_BAR;
    } else {
        S.a_ready(cur);
        PG8_STAGE(PG8_SB(0, 0), cB, voffB); PG8_STAGE(PG8_SA(0, 0), cA, voffA); PG8_STAGE(PG8_SB(0, 1), cB + hstep, voffB); PG8_STAGE(PG8_SA(0, 1), cA + hstep, voffA);
        if (wr == 1) PG8_BAR;
        PG8_WAIT_V(4); PG8_BAR;
        PG8_STAGE(PG8_SB(1, 0), cB + kstep, voffB); PG8_STAGE(PG8_SA(1, 0), cA + kstep, voffA); PG8_STAGE(PG8_SB(1, 1), cB + hstep + kstep, voffB);
        PG8_WAIT_V(6); PG8_BAR;
    }
    for (;;) {
        const bool has_next = S.next(ui + 1, nxt);
        const char* nA = has_next ? (const char*)g.A + (size_t)nxt.pm * tstep : cA; const char* nB = has_next ? (const char*)g.Bt + (size_t)nxt.pn * tstep : cB;
        for (int t = 0; t < nt; t += 2) {
            const bool last = (t == nt - 2);
            const char* a1 = cA + (size_t)(t + 1) * kstep;
            const char* a2 = last ? nA : cA + (size_t)(t + 2) * kstep; const char* b2 = last ? nB : cB + (size_t)(t + 2) * kstep;
            const char* a3 = a2 + kstep; const char* b3 = b2 + kstep;
            if (last && has_next) S.a_ready(nxt);
            if constexpr (SP2) {
            PG8_LDB(B0, 0, 0); PG8_LDB(B1, 0, 1); PG8_SCHED; PG8_LDA(At, 0, 0); PG8_STAGE(PG8_SA(1, 1), a1 + hstep, voffA);
            PG8_WAIT_V(8); PG8_WAIT_L(0); PG8_BAR; PG8_MMA(0, 0, At, B0); PG8_MMA(0, 1, At, B1); PG8_BAR; PG8_SCHED;
            PG8_LDA(At, 0, 1); PG8_STAGE(PG8_SB(0, 0), b2, voffB); PG8_STAGE(PG8_SB(0, 1), b2 + hstep, voffB); PG8_STAGE(PG8_SA(0, 0), a2, voffA);
            PG8_WAIT_V(8); PG8_WAIT_L(0); PG8_BAR; PG8_MMA(1, 0, At, B0); PG8_MMA(1, 1, At, B1); PG8_BAR; PG8_SCHED;
            PG8_LDB(B0, 1, 0); PG8_LDB(B1, 1, 1); PG8_SCHED; PG8_LDA(At, 1, 0); PG8_STAGE(PG8_SA(0, 1), a2 + hstep, voffA);
            PG8_WAIT_V(8); PG8_WAIT_L(0); PG8_BAR; PG8_MMA(0, 0, At, B0); PG8_MMA(0, 1, At, B1); PG8_BAR; PG8_SCHED;
            PG8_LDA(At, 1, 1); PG8_STAGE(PG8_SB(1, 0), b3, voffB); PG8_STAGE(PG8_SB(1, 1), b3 + hstep, voffB); PG8_STAGE(PG8_SA(1, 0), a3, voffA);
            PG8_WAIT_V(8); PG8_WAIT_L(0); PG8_BAR; PG8_MMA(1, 0, At, B0); PG8_MMA(1, 1, At, B1); PG8_BAR; PG8_SCHED;
            } else {
            PG8_LDB(B0, 0, 0); PG8_SCHED; PG8_LDA(At, 0, 0); PG8_STAGE(PG8_SA(1, 1), a1 + hstep, voffA);
            PG8_WAIT_L(8); PG8_BAR; PG8_WAIT_L(0); PG8_MMA(0, 0, At, B0); PG8_BAR; PG8_SCHED;
            PG8_LDB(B1, 0, 1); PG8_STAGE(PG8_SB(0, 0), b2, voffB);
            PG8_BAR; PG8_WAIT_L(0); PG8_MMA(0, 1, At, B1); PG8_BAR;
            PG8_LDA(At, 0, 1); PG8_STAGE(PG8_SA(0, 0), a2, voffA);
            PG8_BAR; PG8_WAIT_L(0); PG8_MMA(1, 0, At, B0); PG8_BAR; PG8_SCHED;
            PG8_STAGE(PG8_SB(0, 1), b2 + hstep, voffB);
            PG8_WAIT_V(6); PG8_BAR; PG8_MMA(1, 1, At, B1); PG8_BAR;
            PG8_LDB(B0, 1, 0); PG8_SCHED; PG8_LDA(At, 1, 0); PG8_STAGE(PG8_SA(0, 1), a2 + hstep, voffA);
            PG8_WAIT_L(8); PG8_BAR; PG8_WAIT_L(0); PG8_MMA(0, 0, At, B0); PG8_BAR; PG8_SCHED;
            PG8_LDB(B1, 1, 1); PG8_STAGE(PG8_SB(1, 0), b3, voffB);
            PG8_BAR; PG8_WAIT_L(0); PG8_MMA(0, 1, At, B1); PG8_BAR;
            PG8_LDA(At, 1, 1); PG8_STAGE(PG8_SA(1, 0), a3, voffA);
            PG8_BAR; PG8_WAIT_L(0); PG8_MMA(1, 0, At, B0); PG8_BAR; PG8_SCHED;
            PG8_STAGE(PG8_SB(1, 1), b3 + hstep, voffB);
            PG8_WAIT_V(6); PG8_BAR; PG8_MMA(1, 1, At, B1); PG8_BAR;
            }
        }
        if constexpr (ALIGN_EPI) { if (wr == 0) PG8_BAR; }
        if constexpr (!Epi::AFTER_DRAIN) { E(acc, cur, wr, wc, fr, fq); S.done(cur); }
        if (!has_next) break;
#pragma unroll
        for (int a = 0; a < 2; ++a)
#pragma unroll
            for (int b = 0; b < 2; ++b)
#pragma unroll
                for (int m = 0; m < 4; ++m)
#pragma unroll
                    for (int n = 0; n < 2; ++n) acc[a][b][m][n] = (f32x4){0.f, 0.f, 0.f, 0.f};
        cur = nxt; cA = nA; cB = nB; ++ui;
        if constexpr (ALIGN_EPI) { if (wr == 1) PG8_BAR; }
    }
    PG8_WAIT_V(0);
    if constexpr (!ALIGN_EPI) { if (wr == 0) PG8_BAR; }
    PG8_BAR;
    if constexpr (Epi::AFTER_DRAIN) { E.fused(acc, cur, wr, wc, fr, fq, lds, wid, lane); S.done(cur); }
#undef PG8_SA
#undef PG8_SB
#undef PG8_STAGE
#undef PG8_LDA
#undef PG8_LDB
#undef PG8_MMA
#undef PG8_WAIT_V
#undef PG8_WAIT_L
#undef PG8_BAR
#undef PG8_SCHED
}
}

#define GAS __attribute__((address_space(1)))
#define LAS __attribute__((address_space(3)))
typedef unsigned short bf16;
typedef unsigned v4u __attribute__((ext_vector_type(4)));
typedef float f32x4 __attribute__((ext_vector_type(4)));
typedef short bf16x8 __attribute__((ext_vector_type(8)));
typedef GAS unsigned gu32;
typedef GAS unsigned long long gu64;
#define RLX_AGENT __ATOMIC_RELAXED, __HIP_MEMORY_SCOPE_AGENT
#define LDS_WAIT() asm volatile("s_waitcnt lgkmcnt(0)" ::: "memory")
#define VM_WAIT() asm volatile("s_waitcnt vmcnt(0)" ::: "memory")
__device__ __forceinline__ unsigned long long rt() { return __builtin_amdgcn_s_memrealtime(); }
__device__ __forceinline__ unsigned pk2(float lo, float hi) { return (unsigned)f2bf(lo) | ((unsigned)f2bf(hi) << 16); }

#define XB_TMO      128
#define XB_XCNT(j)  (256  + 64 * (j))
#define XB_XSUB(j)  (1280 + 64 * (j))
#define XB_XGEN(j)  (2304 + 64 * (j))
#define XB_TOP      3328
#define XB_TOPGEN   3392
#define XCD_BAR_WORDS 3456
#define XB_SPIN_CAP (1u << 18)

__device__ __forceinline__ unsigned xb_ld(unsigned* p)              { return __hip_atomic_load(p, __ATOMIC_RELAXED, __HIP_MEMORY_SCOPE_AGENT); }
__device__ __forceinline__ unsigned xb_add(unsigned* p, unsigned v) { return __hip_atomic_fetch_add(p, v, __ATOMIC_RELAXED, __HIP_MEMORY_SCOPE_AGENT); }
__device__ __forceinline__ unsigned xb_xcc_id() { return (unsigned)__builtin_amdgcn_s_getreg((3 << 11) | 20) & 0xFu; }
#define XB_SPIN(cond, bar) do { unsigned _sp = 0; while (cond) { __builtin_amdgcn_s_sleep(1); \
    if ((++_sp & 255u) == 0u) { if (xb_ld(&(bar)[XB_TMO])) break; if (_sp > XB_SPIN_CAP) { atomicAdd(&(bar)[XB_TMO], 1u); break; } } } } while (0)

struct XcdBarrier {
    unsigned* bar; unsigned x;
    volatile LAS unsigned* st;
};

__device__ __forceinline__ XcdBarrier xcd_barrier_post(unsigned* bar, volatile LAS unsigned* st) {
    XcdBarrier b; b.bar = bar; b.x = xb_xcc_id(); b.st = st;
    if (threadIdx.x == 0) (void)xb_add(&bar[XB_XCNT(b.x)], 1u);
    return b;
}
__device__ __forceinline__ void xcd_barrier_complete(unsigned* bar, unsigned x, unsigned& nloc, unsigned& nx) {
    const unsigned G = gridDim.x * gridDim.y * gridDim.z;
    unsigned sum, cnt, mine, sp = 0u;
    for (;;) {
        sum = 0u; cnt = 0u; mine = 0u;
#pragma unroll
        for (unsigned j = 0; j < 16; ++j) { const unsigned c = xb_ld(&bar[XB_XCNT(j)]); sum += c; cnt += (c > 0u) ? 1u : 0u; mine = (j == x) ? c : mine; }
        if (sum == G) break;
        __builtin_amdgcn_s_sleep(1);
        if ((++sp & 255u) == 0u) { if (xb_ld(&bar[XB_TMO])) break; if (sp > XB_SPIN_CAP) { atomicAdd(&bar[XB_TMO], 1u); break; } }
    }
    nloc = mine > 0u ? mine : 1u; nx = cnt > 0u ? cnt : 1u;
}

__device__ __forceinline__ void xcd_barrier(const XcdBarrier& b) {
    asm volatile("s_waitcnt vmcnt(0)" ::: "memory");
    __syncthreads();
    if (threadIdx.x == 0) {
        unsigned* bar = b.bar;
        __builtin_amdgcn_s_waitcnt(0);
        unsigned nloc = b.st[0], nx = b.st[1];
        if (nloc == 0u) { xcd_barrier_complete(bar, b.x, nloc, nx); b.st[0] = nloc; b.st[1] = nx; }
        const unsigned old = xb_add(&bar[XB_XSUB(b.x)], 1u);
        const unsigned gen = old / nloc;
        if (old + 1u == (gen + 1u) * nloc) {
            __builtin_amdgcn_fence(__ATOMIC_RELEASE, "agent");
            asm volatile("s_waitcnt vmcnt(0)" ::: "memory");
            const unsigned og = xb_add(&bar[XB_TOP], 1u);
            const unsigned tg = og / nx;
            if (og + 1u == (tg + 1u) * nx) xb_add(&bar[XB_TOPGEN], 1u);
            else XB_SPIN(xb_ld(&bar[XB_TOPGEN]) == tg, bar);
            __builtin_amdgcn_fence(__ATOMIC_ACQUIRE, "agent");
            xb_add(&bar[XB_XGEN(b.x)], 1u);
            asm volatile("s_waitcnt vmcnt(0)" ::: "memory");
        } else {
            XB_SPIN(xb_ld(&bar[XB_XGEN(b.x)]) == gen, bar);
            __builtin_amdgcn_fence(__ATOMIC_ACQUIRE, "agent");
            asm volatile("s_waitcnt vmcnt(0)" ::: "memory");
        }
    }
    __syncthreads();
}

constexpr int NWAVES = 8;
constexpr int RING_OFF = 0, RING_BYTES = 131072;
constexpr int LDSCTL_OFF = RING_BYTES, MISC_OFF = LDSCTL_OFF + 320;
constexpr int LDS_BYTES = 147456;
static_assert(MISC_OFF + 128 <= LDS_BYTES, "LDS map");

struct Frame {
    LAS unsigned char* lds;
    volatile LAS unsigned* MISC;
    gu32* ctl;
    int tid, lane, wave;
    int vcu, G;
};

__device__ const double REV_FREQ[32] = {
    0.15915494309189535, 0.11934937021124886, 0.089499401608891013, 0.067115083005227255, 0.050329212104487035, 0.037741584717419771, 0.028302195830623399, 0.02122365276477766,
    0.015915494309189534, 0.011934937021124886, 0.0089499401608891024, 0.0067115083005227253, 0.0050329212104487037, 0.0037741584717419772, 0.0028302195830623399, 0.0021223652764777662,
    0.0015915494309189536, 0.0011934937021124885, 0.00089499401608891024, 0.0006711508300522726, 0.00050329212104487033, 0.00037741584717419774, 0.00028302195830623395, 0.00021223652764777661,
    0.00015915494309189535, 0.00011934937021124886, 8.9499401608891018e-05, 6.7115083005227254e-05, 5.0329212104487035e-05, 3.7741584717419777e-05, 2.8302195830623396e-05, 2.1223652764777659e-05};
template <bool PERMROWS>
__device__ __forceinline__ void p0_transpose_item(const float* W, int K, int N, bf16* WT, const float* kscale, LAS float* scr, int item, int lane) {
    const int nblk = N / 32, kb = item / nblk, nb = item % nblk, k0 = 64 * kb, n0 = 32 * nb;
    float w[32];
#pragma unroll
    for (int i = 0; i < 32; ++i) { const int kk = 2 * i + (lane >> 5); w[i] = W[(size_t)(k0 + kk) * N + n0 + (lane & 31)]; }
    if (kscale) {
#pragma unroll
        for (int i = 0; i < 32; ++i) w[i] *= kscale[k0 + 2 * i + (lane >> 5)];
    }
#pragma unroll
    for (int i = 0; i < 32; ++i) scr[(2 * i + (lane >> 5)) * 33 + (lane & 31)] = w[i];
    LDS_WAIT(); asm volatile("" ::: "memory");
    const int r0 = PERMROWS ? ((int)((SLOT_OF_TILE >> (4 * (n0 >> 8))) & 15ull) * 256 + ((((n0 >> 5) & 1) << 7) | (((n0 >> 6) & 3) << 5))) : n0;
    const int c = lane & 7;
#pragma unroll
    for (int j = 0; j < 4; ++j) { const int n = (lane >> 3) + 8 * j; const LAS float* s = scr + (8 * c) * 33 + n;
        v4u o; o.x = pk2(s[0 * 33], s[1 * 33]); o.y = pk2(s[2 * 33], s[3 * 33]); o.z = pk2(s[4 * 33], s[5 * 33]); o.w = pk2(s[6 * 33], s[7 * 33]);
        *(GAS v4u*)(WT + (size_t)(r0 + n) * K + k0 + 8 * c) = o; }
    LDS_WAIT(); asm volatile("" ::: "memory");
}
__device__ __forceinline__ float wave_sum(float v) {
#pragma unroll
    for (int o = 1; o < 64; o <<= 1) v += __shfl_xor(v, o);
    return v;
}

struct Args { const float* in[9]; float* out; unsigned char* ws; int ph_lo, ph_hi, li, pad; float lg2g[4]; float g128[4]; };

struct P0Item { bool has0, is1; int k0, n0; };
__device__ __forceinline__ void p0_tables_and_item(unsigned char* ws, const float* rel_bias, const float* qnw, const float* knw, const float* norm_w, LAS float* scr, int gw, int NGW, int lane, const P0Item& I, float (&w)[32]) {
    Tabs tb = tabs_of(ws);
    for (int i0 = gw * 64; i0 < SH * WIN + 9; i0 += NGW * 64) {
        float mq = fabsf(qnw[lane]), mk = fabsf(knw[lane]);
#pragma unroll
        for (int o = 1; o < 64; o <<= 1) { mq = fmaxf(mq, __shfl_xor(mq, o)); mk = fmaxf(mk, __shfl_xor(mk, o)); }
        const float A = 8.0f * mq * mk * 1.4426950408889634f;
        const int i = i0 + lane;
        const int hsel = (i < SH * WIN) ? (i >> 7) : (i - SH * WIN);
        float Msel = 0.f; bool ok = true;
#pragma unroll
        for (int hq = 0; hq < SH; ++hq) {
            const float v = rel_bias[(lane & 31) * SH + hq] * 1.4426950408889634f;
            float bmax = v, bmin = v;
#pragma unroll
            for (int o = 1; o < 32; o <<= 1) { bmax = fmaxf(bmax, __shfl_xor(bmax, o)); bmin = fminf(bmin, __shfl_xor(bmin, o)); }
            if (hsel == hq) Msel = A + bmax;
            ok = ok && (2.0f * A + (bmax - bmin) < 100.0f);
        }
        if (i < SH * WIN) {
            const int hq = i >> 7, dist = i & 127;
            int bucket;
            if (dist < 16) bucket = dist;
            else { const float nf = (float)dist; int large = 16 + (int)(logf(nf / 16.0f) / 2.0794415416798357f * 16.0f); bucket = large < 31 ? large : 31; }
            __hip_atomic_store((unsigned*)&tb.biasT[i], __float_as_uint(rel_bias[bucket * SH + hq] * 1.4426950408889634f - Msel), __ATOMIC_RELAXED, __HIP_MEMORY_SCOPE_AGENT);
        } else if (i < SH * WIN + SH) __hip_atomic_store((unsigned*)&tb.biasT[i], __float_as_uint(Msel), __ATOMIC_RELAXED, __HIP_MEMORY_SCOPE_AGENT);
        else if (i == SH * WIN + SH) __hip_atomic_store((unsigned*)&tb.biasT[i], __float_as_uint(ok ? 1.0f : 0.0f), __ATOMIC_RELAXED, __HIP_MEMORY_SCOPE_AGENT);
    }
    if (I.has0) {
        if (I.is1) {
#pragma unroll
            for (int i = 0; i < 32; ++i) w[i] *= norm_w[I.k0 + 2 * i + (lane >> 5)];
        }
#pragma unroll
        for (int i = 0; i < 32; ++i) scr[(2 * i + (lane >> 5)) * 33 + (lane & 31)] = w[i];
        LDS_WAIT(); asm volatile("" ::: "memory");
        const int n0 = I.n0;
        const int r0 = I.is1 ? ((int)((SLOT_OF_TILE >> (4 * (n0 >> 8))) & 15ull) * 256 + ((((n0 >> 5) & 1) << 7) | (((n0 >> 6) & 3) << 5))) : n0;
        bf16* WT = (bf16*)(ws + (I.is1 ? WS_W1 : WS_W2));
        const int c = lane & 7;
#pragma unroll
        for (int j = 0; j < 4; ++j) { const int n = (lane >> 3) + 8 * j; const LAS float* sp = scr + (8 * c) * 33 + n;
            v4u o; o.x = pk2(sp[0 * 33], sp[1 * 33]); o.y = pk2(sp[2 * 33], sp[3 * 33]); o.z = pk2(sp[4 * 33], sp[5 * 33]); o.w = pk2(sp[6 * 33], sp[7 * 33]);
            __builtin_amdgcn_raw_buffer_store_b128(o, __builtin_amdgcn_make_buffer_rsrc((void*)WT, 0, (int)((size_t)DIN * DM * 2), 0x00020000), (int)(((unsigned)(r0 + n) * DM + I.k0 + 8 * c) * 2u), 0, 16); }
        LDS_WAIT(); asm volatile("" ::: "memory");
    }
}
__device__ __forceinline__ void p0_row(const float* x, float* rstd, bf16* xb, int m, int lane) {
    const GAS f32x4* xr = (const GAS f32x4*)(x + (size_t)m * DM) + lane;
    f32x4 v[4]; float sq = 0.f;
#pragma unroll
    for (int j = 0; j < 4; ++j) { v[j] = __builtin_nontemporal_load(xr + 64 * j); sq += (v[j].x * v[j].x + v[j].y * v[j].y) + (v[j].z * v[j].z + v[j].w * v[j].w); }
    sq = wave_sum(sq);
    if (lane == 0) rstd[m] = 1.0f / sqrtf(sq * (1.0f / DM) + NORM_EPS);
    GAS unsigned long long* o8 = (GAS unsigned long long*)(xb + (size_t)m * DM) + lane;
#pragma unroll
    for (int j = 0; j < 4; ++j) o8[64 * j] = (unsigned long long)pk2(v[j].x, v[j].y) | ((unsigned long long)pk2(v[j].z, v[j].w) << 32);
}
__device__ __forceinline__ void p0_prologue(Frame& F, const Args& args) {
    unsigned char* ws = args.ws;
    const float* x = args.in[0]; const float* norm_w = args.in[1]; const float* w_in = args.in[2]; const float* rel_bias = args.in[7]; const float* w_out = args.in[8];
    LAS float* scr = (LAS float*)(F.lds + RING_OFF + F.wave * 16384);
    const int gw = F.vcu * NWAVES + F.wave, NGW = F.G * NWAVES, lane = F.lane;
    float* rstd = (float*)(ws + WS_RSTD); bf16* xb = (bf16*)(ws + WS_XB);
    static_assert(DM == DMIX, "weight copies share the row pitch");
    constexpr int I_1 = (DM / 64) * (DIN / 32), I_2 = (DMIX / 64) * (DM / 32);
    P0Item I; I.has0 = gw < I_1 + I_2; I.is1 = gw < I_1;
    const float* W = I.is1 ? w_in : w_out; const int N = I.is1 ? DIN : DM; const int item = I.is1 ? gw : gw - I_1;
    { const int nblk = N / 32; I.k0 = 64 * (item / nblk); I.n0 = 32 * (item % nblk); }
    float w[32];
#pragma unroll
    for (int i = 0; i < 32; ++i) w[i] = 0.f;
    if (I.has0) {
#pragma unroll
        for (int i = 0; i < 32; ++i) w[i] = __builtin_nontemporal_load(W + (size_t)(I.k0 + 2 * i + (lane >> 5)) * N + I.n0 + (lane & 31));
    }
    bool did = false;
    int m0 = gw;
    for (; m0 + 7 * NGW < T; m0 += 8 * NGW) {
        f32x4 v[8][4];
#pragma unroll
        for (int r = 0; r < 8; ++r) { const GAS f32x4* xr = (const GAS f32x4*)(x + (size_t)(m0 + r * NGW) * DM) + lane;
#pragma unroll
            for (int j = 0; j < 4; ++j) v[r][j] = __builtin_nontemporal_load(xr + 64 * j); }
        if (!did) { p0_tables_and_item(ws, rel_bias, args.in[4], args.in[5], norm_w, scr, gw, NGW, lane, I, w); did = true; }
#pragma unroll
        for (int r = 0; r < 8; ++r) {
            float sq = 0.f;
#pragma unroll
            for (int j = 0; j < 4; ++j) sq += (v[r][j].x * v[r][j].x + v[r][j].y * v[r][j].y) + (v[r][j].z * v[r][j].z + v[r][j].w * v[r][j].w);
            sq = wave_sum(sq);
            if (lane == 0) rstd[m0 + r * NGW] = 1.0f / sqrtf(sq * (1.0f / DM) + NORM_EPS);
            GAS unsigned long long* o8 = (GAS unsigned long long*)(xb + (size_t)(m0 + r * NGW) * DM) + lane;
#pragma unroll
            for (int j = 0; j < 4; ++j) o8[64 * j] = (unsigned long long)pk2(v[r][j].x, v[r][j].y) | ((unsigned long long)pk2(v[r][j].z, v[r][j].w) << 32);
        }
    }
    if (!did) p0_tables_and_item(ws, rel_bias, args.in[4], args.in[5], norm_w, scr, gw, NGW, lane, I, w);
    for (; m0 < T; m0 += NGW) p0_row(x, rstd, xb, m0, lane);
    for (int it = gw + NGW; it < I_1 + I_2; it += NGW) {
        if (it < I_1) p0_transpose_item<true>(w_in, DM, DIN, (bf16*)(ws + WS_W1), norm_w, scr, it, lane);
        else p0_transpose_item<false>(w_out, DMIX, DM, (bf16*)(ws + WS_W2), nullptr, scr, it - I_1, lane);
    }
}

template <int R, class Hook>
__device__ __forceinline__ void p0_rows(const float* x, float* rstd, bf16* xb, int m0, int stride, int lane, Hook hook) {
    f32x4 v[R][4];
#pragma unroll
    for (int r = 0; r < R; ++r) { const GAS f32x4* xr = (const GAS f32x4*)(x + (size_t)(m0 + r * stride) * DM) + lane;
#pragma unroll
        for (int j = 0; j < 4; ++j) v[r][j] = __builtin_nontemporal_load(xr + 64 * j); }
    hook();
#pragma unroll
    for (int r = 0; r < R; ++r) {
        float sq = 0.f;
#pragma unroll
        for (int j = 0; j < 4; ++j) sq += (v[r][j].x * v[r][j].x + v[r][j].y * v[r][j].y) + (v[r][j].z * v[r][j].z + v[r][j].w * v[r][j].w);
        sq = wave_sum(sq);
        if (lane == 0) rstd[m0 + r * stride] = 1.0f / sqrtf(sq * (1.0f / DM) + NORM_EPS);
        GAS unsigned long long* o8 = (GAS unsigned long long*)(xb + (size_t)(m0 + r * stride) * DM) + lane;
#pragma unroll
        for (int j = 0; j < 4; ++j) o8[64 * j] = (unsigned long long)pk2(v[r][j].x, v[r][j].y) | ((unsigned long long)pk2(v[r][j].z, v[r][j].w) << 32);
    }
}
__device__ __forceinline__ void p0_split(Frame& F, const Args& args, int grp, int jg, gu32* wcnt) {
    unsigned char* ws = args.ws;
    const float* norm_w = args.in[1]; const float* w_in = args.in[2]; const float* rel_bias = args.in[7]; const float* w_out = args.in[8];
    LAS float* scr = (LAS float*)(F.lds + RING_OFF + F.wave * 16384);
    const int gw = F.vcu * NWAVES + F.wave, NGW = F.G * NWAVES, lane = F.lane;
    constexpr int I_1 = (DM / 64) * (DIN / 32), I_2 = (DMIX / 64) * (DM / 32);
    static_assert(I_1 + I_2 <= 256 * NWAVES, "one weight item per wave");
    P0Item I; I.has0 = gw < I_1 + I_2; I.is1 = gw < I_1;
    const float* W = I.is1 ? w_in : w_out; const int N = I.is1 ? DIN : DM; const int item = I.is1 ? gw : gw - I_1;
    { const int nblk = N / 32; I.k0 = 64 * (item / nblk); I.n0 = 32 * (item % nblk); }
    float w[32];
#pragma unroll
    for (int i = 0; i < 32; ++i) w[i] = 0.f;
    if (I.has0) {
#pragma unroll
        for (int i = 0; i < 32; ++i) w[i] = __builtin_nontemporal_load(W + (size_t)(I.k0 + 2 * i + (lane >> 5)) * N + I.n0 + (lane & 31));
    }
    const int tid = F.tid;
    unsigned tw = 0u;
    {
        const int n0w = I.n0; const int r0w = I.is1 ? ((int)((SLOT_OF_TILE >> (4 * (n0w >> 8))) & 15ull) * 256 + ((((n0w >> 5) & 1) << 7) | (((n0w >> 6) & 3) << 5))) : n0w;
        const int m0w = (grp * 8 + (jg & 7)) * 256 + (jg >> 3) * 64 + F.wave;
        const void* aw = (lane == 0) ? (const void*)((const bf16*)(ws + WS_XB) + (size_t)m0w * DM) : (lane == 1) ? (const void*)((const float*)(ws + WS_RSTD) + m0w)
                       : (const void*)((const bf16*)(ws + (I.is1 ? WS_W1 : WS_W2)) + (size_t)(I.has0 ? r0w : 0) * DM + (I.has0 ? I.k0 : 0));
        if (lane < 3) asm volatile("global_load_dword %0, %1, off" : "+v"(tw) : "v"(aw) : "memory");
    }
    auto hook = [&]() {
        p0_tables_and_item(ws, rel_bias, args.in[4], args.in[5], norm_w, scr, gw, NGW, lane, I, w);
        asm volatile("s_waitcnt vmcnt(0)" :: "v"(tw) : "memory");
        __syncthreads();
        if (tid == 0) (void)__hip_atomic_fetch_add((unsigned*)wcnt, 1u, __ATOMIC_RELAXED, __HIP_MEMORY_SCOPE_AGENT);
    };
    p0_rows<8>(args.in[0], (float*)(ws + WS_RSTD), (bf16*)(ws + WS_XB), (grp * 8 + (jg & 7)) * 256 + (jg >> 3) * 64 + F.wave, NWAVES, lane, hook);
}

namespace mid {
typedef short bf16x8 __attribute__((ext_vector_type(8)));
typedef short s16x4 __attribute__((ext_vector_type(4)));
typedef short v4i16_t __attribute__((ext_vector_type(4)));
typedef float f32x16 __attribute__((ext_vector_type(16)));
typedef float f32x2_t __attribute__((ext_vector_type(2)));
typedef __bf16 bf16x2_t __attribute__((ext_vector_type(2)));
#define MDI __device__ __forceinline__
MDI f32x16 mfma32(bf16x8 a, bf16x8 b, f32x16 c) { return __builtin_amdgcn_mfma_f32_32x32x16_bf16(a, b, c, 0, 0, 0); }
MDI int crow(int r, int hi) { return (r & 3) + 8 * (r >> 2) + 4 * hi; }
MDI unsigned cvtpk(float lo, float hi) { f32x2_t v = {lo, hi}; bf16x2_t b = __builtin_convertvector(v, bf16x2_t); return __builtin_bit_cast(unsigned, b); }
MDI bf16x8 pack8(const f32x16& x, int s) { v4u p; p.x = cvtpk(x[8 * s], x[8 * s + 1]); p.y = cvtpk(x[8 * s + 2], x[8 * s + 3]); p.z = cvtpk(x[8 * s + 4], x[8 * s + 5]); p.w = cvtpk(x[8 * s + 6], x[8 * s + 7]); return __builtin_bit_cast(bf16x8, p); }
MDI s16x4 vtr(LAS const unsigned char* p) { return __builtin_bit_cast(s16x4, __builtin_amdgcn_ds_read_tr16_b64_v4i16((LAS v4i16_t*)p)); }
MDI bf16x8 tr8(LAS const unsigned char* p, int off2) { const s16x4 lo = vtr(p), hi = vtr(p + off2); return (bf16x8){lo[0], lo[1], lo[2], lo[3], hi[0], hi[1], hi[2], hi[3]}; }
MDI float lo_bf(unsigned w) { return __uint_as_float(w << 16); }
MDI float hi_bf(unsigned w) { return __uint_as_float(w & 0xffff0000u); }
MDI int timg(int row, int ch  , int bstride) { return (ch >> 2) * bstride + (row >> 4) * 1024 + (row & 15) * 64 + (ch & 3) * 16; }

constexpr int SW_K = 0, SW_V = 32768, SW_B = 65536, SW_S = 69632;
MDI void swa_loadkv(v4u (&kv)[4], v4u (&vv)[4], const bf16* P, int b, int n, int hkv, int tid) {
    const char* base = (const char*)(P + PXT(O_SK >> 8, (long)b * SEQ + (long)(n - 1) * CH, hkv * 64));
#pragma unroll
    for (int i = 0; i < 4; ++i) {
        const int id = tid + 512 * i, row = id >> 3, ch = id & 7;
        const unsigned off = (unsigned)row * 512u + (unsigned)ch * 16u;
        kv[i] = (v4u){0u, 0u, 0u, 0u}; vv[i] = (v4u){0u, 0u, 0u, 0u};
        if (n > 0 || row >= CH) { kv[i] = *(const v4u*)(base + off); vv[i] = *(const v4u*)(base + off + (O_SV - O_SK) * 2); }
    }
}
#define SWA_SB() __builtin_amdgcn_sched_barrier(0)
MDI void swa_units(LAS unsigned char* lds, const bf16* P, bf16* mixed, const float* biasT, const float* sinks, int b, int su0, int nunits, int sb_begin, int sb_end, int tid, int lane, int wave) {
    const int r32 = lane & 31, hi = lane >> 5;
    const int g = wave >> 1, half = wave & 1;
    const int lanepart = r32 - 4 * hi;
    const LAS float* bl = (const LAS float*)(lds + SW_B) + g * 192 + 31 - lanepart;
    const LAS float* bdead = (const LAS float*)(lds + SW_B) + 4 * 192 + 31 - lanepart;
    const int troff = (4 * hi + ((lane & 15) >> 2)) * 64 + ((lane >> 4) & 1) * 32 + (lane & 3) * 8;
#pragma unroll 1
    for (int k = 0; k < nunits; ++k) {
        const int su = su0 + k, n = su >> 1, hkv = su & 1, hq = hkv * 4 + g;
        {
            v4u kv[4], vv[4];
            swa_loadkv(kv, vv, P, b, n, hkv, tid);
            { LAS float* bt = (LAS float*)(lds + SW_B); const int gg = tid >> 7, dd = tid & 127;
              bt[gg * 192 + 159 - dd] = biasT[hkv * 4 * WIN + tid];
              if (tid < 256) bt[(tid >> 6) * 192 + ((tid & 32) ? 160 : 0) + (tid & 31)] = -1e30f;
              if (tid < 192) bt[4 * 192 + tid] = -1e30f; }
#pragma unroll
            for (int i = 0; i < 4; ++i) {
                const int id = tid + 512 * i, row = id >> 3, ch = id & 7;
                *(LAS v4u*)(lds + SW_K + row * 128 + ((ch ^ ((row >> 1) & 7)) << 4)) = kv[i];
                *(LAS v4u*)(lds + SW_V + timg(row, ch, 16384)) = vv[i];
            }
        }
        const float sink = sinks[hq] * 1.4426950408889634f - biasT[SH * WIN + hq];
        const bool fixed_shift = biasT[SH * WIN + SH] != 0.f;
        const size_t trow0 = (size_t)b * SEQ + n * CH + 64 * half;
        const bf16* Pq = P + PXT((O_SQ >> 8) + (hq >> 2), trow0, (hq & 3) * 64);
        bf16x8 qf[4];
#pragma unroll
        for (int s = 0; s < 4; ++s) qf[s] = *(const bf16x8*)(Pq + ((32 * sb_begin + r32) * 256 + s * 16 + hi * 8));
        __syncthreads();
#pragma unroll 1
        for (int sb = sb_begin; sb < sb_end; ++sb) {
            const int q0 = 64 * half + 32 * sb, jt0 = q0 >> 5;
            f32x16 S[5]; bf16x8 kfr[5][4];
#pragma unroll
            for (int lt = 0; lt < 5; ++lt) {
                const LAS float* bp = (n == 0 && jt0 + lt < 4) ? bdead : bl;
#pragma unroll
                for (int r = 0; r < 16; ++r) S[lt][r] = bp[32 * lt + (r & 3) + 8 * (r >> 2)];
            }
#pragma unroll
            for (int lt = 0; lt < 5; ++lt) {
                const int row = 32 * (jt0 + lt) + r32;
#pragma unroll
                for (int s = 0; s < 4; ++s) { const int c = 2 * s + hi; kfr[lt][s] = *(const LAS bf16x8*)(lds + SW_K + row * 128 + ((c ^ ((row >> 1) & 7)) << 4)); }
            }
            SWA_SB();
#pragma unroll
            for (int s = 0; s < 4; ++s)
#pragma unroll
                for (int lt = 0; lt < 5; ++lt) S[lt] = mfma32(kfr[lt][s], qf[s], S[lt]);
            SWA_SB();
            v4u gt[4];
#pragma unroll
            for (int i = 0; i < 4; ++i) gt[i] = *(const v4u*)(Pq + (size_t)((O_SG - O_SQ) >> 8) * T * 256 + ((32 * sb + i * 8 + (lane >> 3)) * 256 + (lane & 7) * 8));
            bf16x8 qn[4];
            if (sb + 1 < sb_end) {
#pragma unroll
                for (int s = 0; s < 4; ++s) qn[s] = *(const bf16x8*)(Pq + ((32 * (sb + 1) + r32) * 256 + s * 16 + hi * 8));
            } else {
#pragma unroll
                for (int s = 0; s < 4; ++s) qn[s] = qf[s];
            }
            float sk = sink;
            if (!fixed_shift) {
                float m = sink;
#pragma unroll
                for (int lt = 0; lt < 5; ++lt)
#pragma unroll
                    for (int r = 0; r < 16; ++r) m = fmaxf(m, S[lt][r]);
                m = fmaxf(m, __shfl_xor(m, 32));
#pragma unroll
                for (int lt = 0; lt < 5; ++lt)
#pragma unroll
                    for (int r = 0; r < 16; ++r) S[lt][r] -= m;
                sk = sink - m;
            }
            float l4[4] = {0.f, 0.f, 0.f, 0.f};
            bf16x8 pa[5][2];
#pragma unroll
            for (int lt = 0; lt < 5; ++lt) {
#pragma unroll
                for (int r = 0; r < 16; ++r) { const float p = __builtin_amdgcn_exp2f(S[lt][r]); S[lt][r] = p; l4[r & 3] += p; }
                pa[lt][0] = pack8(S[lt], 0); pa[lt][1] = pack8(S[lt], 1);
            }
            float l = (l4[0] + l4[1]) + (l4[2] + l4[3]);
            l += __shfl_xor(l, 32); l += __builtin_amdgcn_exp2f(sk);
            const float linv = __builtin_amdgcn_rcpf(l);
            LAS float* wl = (LAS float*)(lds + SW_S + 8 * 4096) + wave * 32;
            if (hi == 0) wl[r32] = linv;
            f32x16 o[2];
#pragma unroll
            for (int d0 = 0; d0 < 2; ++d0) {
                bf16x8 vf[10];
#pragma unroll
                for (int i = 0; i < 10; ++i) vf[i] = tr8(lds + SW_V + d0 * 16384 + (2 * jt0 + i) * 1024 + troff, 512);
                SWA_SB();
                f32x16 oa = {}, ob = {};
#pragma unroll
                for (int lt = 0; lt < 5; ++lt) { oa = mfma32(pa[lt][0], vf[2 * lt], oa); ob = mfma32(pa[lt][1], vf[2 * lt + 1], ob); }
                o[d0] = oa + ob;
                SWA_SB();
            }
            LAS bf16* stg = (LAS bf16*)(lds + SW_S + wave * 4096);
            LDS_WAIT();
#pragma unroll
            for (int r = 0; r < 16; ++r) { const float li = wl[4 * hi + (r & 3) + 8 * (r >> 2)];
#pragma unroll
                for (int d0 = 0; d0 < 2; ++d0) stg[(4 * hi + (r & 3) + 8 * (r >> 2)) * 64 + d0 * 32 + r32] = (bf16)cvtpk(o[d0][r] * li, 0.f); }
            LDS_WAIT();
#pragma unroll
            for (int i = 0; i < 4; ++i) {
                const int row = i * 8 + (lane >> 3), ch = lane & 7;
                const v4u ov = *(const LAS v4u*)(stg + row * 64 + ch * 8);
                const size_t t = (size_t)b * SEQ + n * CH + q0 + row;
                const v4u gv = gt[i];
                v4u res;
                res.x = cvtpk(lo_bf(ov.x) * lo_bf(gv.x), hi_bf(ov.x) * hi_bf(gv.x)); res.y = cvtpk(lo_bf(ov.y) * lo_bf(gv.y), hi_bf(ov.y) * hi_bf(gv.y));
                res.z = cvtpk(lo_bf(ov.z) * lo_bf(gv.z), hi_bf(ov.z) * hi_bf(gv.z)); res.w = cvtpk(lo_bf(ov.w) * lo_bf(gv.w), hi_bf(ov.w) * hi_bf(gv.w));
                *(v4u*)(mixed + t * DMIX + 512 + hq * 64 + ch * 8) = res;
            }
            LDS_WAIT();
#pragma unroll
            for (int s = 0; s < 4; ++s) qf[s] = qn[s];
        }
        __syncthreads();
    }
}

constexpr int PF_BUF = 32768;
#define PF_LOAD(KR, VR, NN) do { _Pragma("unroll") for (int i_ = 0; i_ < 2; ++i_) { const int id_ = tid + 512 * i_, j_ = id_ >> 3, ch_ = id_ & 7; const size_t row_ = tb + (size_t)(NN) * CH; const int lo_ = j_ * 256 + ch_ * 8; \
        KR[i_] = *(const v4u*)(P + PXT(O_RK >> 8, row_, h * 64) + lo_); VR[i_] = *(const v4u*)(P + PXT((O_RV >> 8) + (h >> 1), row_, (h & 1) * 128 + eh * 64) + lo_); } } while (0)
#define PF_STEP(KR, VR, NN) do { \
        LAS unsigned char* buf = lds + ((NN) & 1) * PF_BUF; \
        _Pragma("unroll") for (int i_ = 0; i_ < 2; ++i_) { const int id_ = tid + 512 * i_, j_ = id_ >> 3, ch_ = id_ & 7; \
            *(LAS v4u*)(buf + timg(j_, ch_, 8192)) = KR[i_]; *(LAS v4u*)(buf + 16384 + timg(j_, ch_, 8192)) = VR[i_]; } \
        if ((NN) + 4 < NCH) PF_LOAD(KR, VR, (NN) + 4); \
        __syncthreads(); \
        if (wave < 4) { \
            bf16* dst = prevT + (size_t)(NN) * 8192 + (size_t)(64 * eh + 32 * eb + r32) * 64 + 32 * db + 4 * hi; \
            _Pragma("unroll") for (int g4 = 0; g4 < 4; ++g4) { \
                const unsigned long long w_ = (unsigned long long)cvtpk(st[4 * g4], st[4 * g4 + 1]) | ((unsigned long long)cvtpk(st[4 * g4 + 2], st[4 * g4 + 3]) << 32); \
                *(unsigned long long*)(dst + 8 * g4) = w_; } \
            bf16x8 ka_[8], va_[8]; \
            _Pragma("unroll") for (int ks = 0; ks < 8; ++ks) { ka_[ks] = tr8(buf + db * 8192 + ks * 1024 + troff, 512); va_[ks] = tr8(buf + 16384 + eb * 8192 + ks * 1024 + troff, 512); } \
            __builtin_amdgcn_sched_barrier(0); \
            f32x16 acc0 = {}, acc1 = {}; \
            _Pragma("unroll") for (int ks = 0; ks < 8; ks += 2) { acc0 = mfma32(ka_[ks], va_[ks], acc0); acc1 = mfma32(ka_[ks + 1], va_[ks + 1], acc1); } \
            st = (st + (acc0 + acc1)) * gC; } } while (0)
MDI void prefix_unit(LAS unsigned char* lds, const bf16* P, bf16* prevT, float gC, int b, int h, int eh, int tid, int lane, int wave) {
    const int r32 = lane & 31, hi = lane >> 5;
    const size_t tb = (size_t)b * SEQ;
    v4u krA[2], vrA[2], krB[2], vrB[2], krC[2], vrC[2], krD[2], vrD[2];
    PF_LOAD(krA, vrA, 0); PF_LOAD(krB, vrB, 1); PF_LOAD(krC, vrC, 2); PF_LOAD(krD, vrD, 3);
    f32x16 st = {};
    const int db = (wave >> 1) & 1, eb = wave & 1;
    const int troff = (4 * hi + ((lane & 15) >> 2)) * 64 + ((lane >> 4) & 1) * 32 + (lane & 3) * 8;
#pragma unroll 1
    for (int n = 0; n < NCH; n += 4) { PF_STEP(krA, vrA, n); PF_STEP(krB, vrB, n + 1); PF_STEP(krC, vrC, n + 2); PF_STEP(krD, vrD, n + 3); }
    __syncthreads();
}

constexpr int KV_K = 0, KV_V = 16384, RT_P = 49152, RT_ST = 73728, RT_STG_STRIDE = 8704;
template <class Hook>
MDI void ret_unit(LAS unsigned char* lds, const bf16* P, bf16* mixed, const bf16* prevT, const float* ret_norm_w, int b, int h, int n, int tid, int lane, int wave, Hook hook) {
    const int r32 = lane & 31, hi = lane >> 5;
    const size_t t0 = (size_t)b * SEQ + n * CH;
    v4u kreg[2], vreg[4], preg[2];
#pragma unroll
    for (int i = 0; i < 2; ++i) { const int id = tid + 512 * i, j = id >> 3, ch = id & 7; kreg[i] = *(const v4u*)(P + PXT(O_RK >> 8, t0, h * 64) + (j * 256 + ch * 8)); preg[i] = *(const v4u*)(prevT + (size_t)j * 64 + ch * 8); }
#pragma unroll
    for (int i = 0; i < 4; ++i) { const int id = tid + 512 * i, j = id >> 4, ch = id & 15; vreg[i] = *(const v4u*)(P + PXT((O_RV >> 8) + (h >> 1), t0, (h & 1) * 128) + (j * 256 + ch * 8)); }
    const int qb = (wave < 4) ? (wave >> 1) : 3 - ((wave - 4) >> 1), eh = wave & 1;
    bf16x8 qf[4];
#pragma unroll
    for (int s = 0; s < 4; ++s) qf[s] = *(const bf16x8*)(P + PXT(O_RQ >> 8, t0 + 32 * qb, h * 64) + (r32 * 256 + s * 16 + hi * 8));
    v4u gv[4];
#pragma unroll
    for (int i = 0; i < 4; ++i) gv[i] = *(const v4u*)(P + PXT((O_RG >> 8) + (h >> 1), t0 + 32 * qb, (h & 1) * 128 + 64 * eh) + ((i * 8 + (lane >> 3)) * 256 + (lane & 7) * 8));
    const f32x4 n0 = *(const f32x4*)(ret_norm_w + h * 128 + 64 * eh + (lane & 7) * 8), n1 = *(const f32x4*)(ret_norm_w + h * 128 + 64 * eh + (lane & 7) * 8 + 4);
#pragma unroll
    for (int i = 0; i < 2; ++i) { const int id = tid + 512 * i, j = id >> 3, ch = id & 7; const int off = j * 128 + ((ch ^ ((j >> 1) & 7)) << 4);
        *(LAS v4u*)(lds + KV_K + off) = kreg[i]; *(LAS v4u*)(lds + RT_P + off) = preg[i]; }
#pragma unroll
    for (int i = 0; i < 4; ++i) { const int id = tid + 512 * i, j = id >> 4, ch = id & 15; *(LAS v4u*)(lds + KV_V + timg(j, ch, 8192)) = vreg[i]; }
    asm volatile("" :: "v"(gv[0]), "v"(gv[1]), "v"(gv[2]), "v"(gv[3]), "v"(n0), "v"(n1), "v"(qf[0]), "v"(qf[1]), "v"(qf[2]), "v"(qf[3]));
    __syncthreads();
    hook();
    f32x16 o[2]; o[0] = (f32x16){}; o[1] = (f32x16){};
    const int tq = ((lane & 15) >> 2) * 64 + ((lane >> 4) & 1) * 32 + (lane & 3) * 8;
#pragma unroll
    for (int s = 0; s < 4; ++s)
#pragma unroll
        for (int eb = 0; eb < 2; ++eb) { const int row = 32 * (2 * eh + eb) + r32, c = 2 * s + hi;
            const bf16x8 a = *(const LAS bf16x8*)(lds + RT_P + row * 128 + ((c ^ ((row >> 1) & 7)) << 4)); o[eb] = mfma32(a, qf[s], o[eb]); }
#pragma unroll 1
    for (int jt = 0; jt <= qb; ++jt) {
        const int row = 32 * jt + r32;
        f32x16 acc = {};
#pragma unroll
        for (int s = 0; s < 4; ++s) { const int c = 2 * s + hi; const bf16x8 kf = *(const LAS bf16x8*)(lds + KV_K + row * 128 + ((c ^ ((row >> 1) & 7)) << 4)); acc = mfma32(kf, qf[s], acc); }
        if (jt == qb) {
#pragma unroll
            for (int r = 0; r < 16; ++r) acc[r] = (crow(r, hi) > r32) ? 0.f : acc[r];
        }
#pragma unroll
        for (int s2 = 0; s2 < 2; ++s2) {
            const bf16x8 pb = pack8(acc, s2); const int ks = 2 * jt + s2;
#pragma unroll
            for (int eb = 0; eb < 2; ++eb) { const bf16x8 a = tr8(lds + KV_V + (2 * eh + eb) * 8192 + ks * 1024 + 4 * hi * 64 + tq, 512); o[eb] = mfma32(a, pb, o[eb]); }
        }
    }
    float s1 = 0.f;
#pragma unroll
    for (int eb = 0; eb < 2; ++eb)
#pragma unroll
        for (int r = 0; r < 16; ++r) s1 += o[eb][r];
    s1 += __shfl_xor(s1, 32);
    const float mean64 = s1 * (1.0f / 64.0f);
    float m2 = 0.f;
#pragma unroll
    for (int eb = 0; eb < 2; ++eb)
#pragma unroll
        for (int r = 0; r < 16; ++r) { const float dd = o[eb][r] - mean64; m2 += dd * dd; }
    m2 += __shfl_xor(m2, 32);
    LAS f32x2_t* stats = (LAS f32x2_t*)(lds + RT_ST);
    if (hi == 0) stats[(qb * 2 + eh) * 32 + r32] = (f32x2_t){mean64, m2};
    __syncthreads();
    const f32x2_t ot = stats[(qb * 2 + (eh ^ 1)) * 32 + r32];
    const float mean = 0.5f * (mean64 + ot.x), dm = mean64 - ot.x;
    const float var = (m2 + ot.y + 32.0f * dm * dm) * (1.0f / 128.0f);
    const float rstd = 1.0f / sqrtf(var + GN_EPS);
    LAS float* st = (LAS float*)(lds + wave * RT_STG_STRIDE);
#pragma unroll
    for (int eb = 0; eb < 2; ++eb)
#pragma unroll
        for (int g4 = 0; g4 < 4; ++g4) {
            f32x4 v; v[0] = (o[eb][4 * g4 + 0] - mean) * rstd; v[1] = (o[eb][4 * g4 + 1] - mean) * rstd; v[2] = (o[eb][4 * g4 + 2] - mean) * rstd; v[3] = (o[eb][4 * g4 + 3] - mean) * rstd;
            *(LAS f32x4*)(st + r32 * 68 + eb * 32 + 8 * g4 + 4 * hi) = v;
        }
    LDS_WAIT();
    {
        const int ch = lane & 7, e = 64 * eh + ch * 8;
#pragma unroll
        for (int i = 0; i < 4; ++i) {
            const int q = i * 8 + (lane >> 3);
            const f32x4 a0 = *(const LAS f32x4*)(st + q * 68 + ch * 8), a1 = *(const LAS f32x4*)(st + q * 68 + ch * 8 + 4);
            const size_t t = t0 + 32 * qb + q;
            v4u res;
            res.x = cvtpk(a0[0] * n0[0] * lo_bf(gv[i].x), a0[1] * n0[1] * hi_bf(gv[i].x)); res.y = cvtpk(a0[2] * n0[2] * lo_bf(gv[i].y), a0[3] * n0[3] * hi_bf(gv[i].y));
            res.z = cvtpk(a1[0] * n1[0] * lo_bf(gv[i].z), a1[1] * n1[1] * hi_bf(gv[i].z)); res.w = cvtpk(a1[2] * n1[2] * lo_bf(gv[i].w), a1[3] * n1[3] * hi_bf(gv[i].w));
            *(v4u*)(mixed + t * DMIX + h * 128 + e) = res;
        }
    }
    LDS_WAIT();
    __syncthreads();
}

constexpr int RP_B = 65536, RP_ST = 131072 + 1024, RP_STG7 = 131072 + 5120;
static_assert(RP_STG7 + RT_STG_STRIDE <= LDS_BYTES && MISC_OFF + 128 <= RP_ST && RP_ST + 4096 <= RP_STG7 && 7 * RT_STG_STRIDE <= RP_B, "retention pair LDS map");
MDI void rp_compute(LAS const unsigned char* img, const bf16x8 (&qf)[4], f32x16 (&o)[2], int qb, int eh, int r32, int hi, int lane) {
    o[0] = (f32x16){}; o[1] = (f32x16){};
    const int tq = ((lane & 15) >> 2) * 64 + ((lane >> 4) & 1) * 32 + (lane & 3) * 8;
#pragma unroll
    for (int s = 0; s < 4; ++s)
#pragma unroll
        for (int eb = 0; eb < 2; ++eb) { const int row = 32 * (2 * eh + eb) + r32, c = 2 * s + hi;
            const bf16x8 a = *(const LAS bf16x8*)(img + RT_P + row * 128 + ((c ^ ((row >> 1) & 7)) << 4)); o[eb] = mfma32(a, qf[s], o[eb]); }
#pragma unroll 1
    for (int jt = 0; jt <= qb; ++jt) {
        const int row = 32 * jt + r32;
        f32x16 acc = {};
#pragma unroll
        for (int s = 0; s < 4; ++s) { const int c = 2 * s + hi; const bf16x8 kf = *(const LAS bf16x8*)(img + KV_K + row * 128 + ((c ^ ((row >> 1) & 7)) << 4)); acc = mfma32(kf, qf[s], acc); }
        if (jt == qb) {
#pragma unroll
            for (int r = 0; r < 16; ++r) acc[r] = (crow(r, hi) > r32) ? 0.f : acc[r];
        }
#pragma unroll
        for (int s2 = 0; s2 < 2; ++s2) {
            const bf16x8 pb = pack8(acc, s2); const int ks = 2 * jt + s2;
#pragma unroll
            for (int eb = 0; eb < 2; ++eb) { const bf16x8 a = tr8(img + KV_V + (2 * eh + eb) * 8192 + ks * 1024 + 4 * hi * 64 + tq, 512); o[eb] = mfma32(a, pb, o[eb]); }
        }
    }
}
MDI void rp_stats(const f32x16 (&o)[2], LAS f32x2_t* stats, float& mean64, float& m2, int qb, int eh, int r32, int hi) {
    float s1 = 0.f;
#pragma unroll
    for (int eb = 0; eb < 2; ++eb)
#pragma unroll
        for (int r = 0; r < 16; ++r) s1 += o[eb][r];
    s1 += __shfl_xor(s1, 32);
    mean64 = s1 * (1.0f / 64.0f);
    m2 = 0.f;
#pragma unroll
    for (int eb = 0; eb < 2; ++eb)
#pragma unroll
        for (int r = 0; r < 16; ++r) { const float dd = o[eb][r] - mean64; m2 += dd * dd; }
    m2 += __shfl_xor(m2, 32);
    if (hi == 0) stats[(qb * 2 + eh) * 32 + r32] = (f32x2_t){mean64, m2};
}
MDI void rp_finish(const f32x16 (&o)[2], const LAS f32x2_t* stats, float mean64, float m2, LAS float* st, const v4u (&gv)[4], const f32x4 n0, const f32x4 n1, bf16* mixed, size_t trow, int h, int qb, int eh, int r32, int hi, int lane) {
    const f32x2_t ot = stats[(qb * 2 + (eh ^ 1)) * 32 + r32];
    const float mean = 0.5f * (mean64 + ot.x), dm = mean64 - ot.x;
    const float var = (m2 + ot.y + 32.0f * dm * dm) * (1.0f / 128.0f);
    const float rstd = 1.0f / sqrtf(var + GN_EPS);
#pragma unroll
    for (int eb = 0; eb < 2; ++eb)
#pragma unroll
        for (int g4 = 0; g4 < 4; ++g4) {
            f32x4 v; v[0] = (o[eb][4 * g4 + 0] - mean) * rstd; v[1] = (o[eb][4 * g4 + 1] - mean) * rstd; v[2] = (o[eb][4 * g4 + 2] - mean) * rstd; v[3] = (o[eb][4 * g4 + 3] - mean) * rstd;
            *(LAS f32x4*)(st + r32 * 68 + eb * 32 + 8 * g4 + 4 * hi) = v;
        }
    LDS_WAIT();
    const int ch = lane & 7, e = 64 * eh + ch * 8;
#pragma unroll
    for (int i = 0; i < 4; ++i) {
        const int q = i * 8 + (lane >> 3);
        const f32x4 a0 = *(const LAS f32x4*)(st + q * 68 + ch * 8), a1 = *(const LAS f32x4*)(st + q * 68 + ch * 8 + 4);
        v4u res;
        res.x = cvtpk(a0[0] * n0[0] * lo_bf(gv[i].x), a0[1] * n0[1] * hi_bf(gv[i].x)); res.y = cvtpk(a0[2] * n0[2] * lo_bf(gv[i].y), a0[3] * n0[3] * hi_bf(gv[i].y));
        res.z = cvtpk(a1[0] * n1[0] * lo_bf(gv[i].z), a1[1] * n1[1] * hi_bf(gv[i].z)); res.w = cvtpk(a1[2] * n1[2] * lo_bf(gv[i].w), a1[3] * n1[3] * hi_bf(gv[i].w));
        *(v4u*)(mixed + (trow + q) * DMIX + h * 128 + e) = res;
    }
    LDS_WAIT();
}
template <class Hook, class Hook2>
MDI void ret_pair(LAS unsigned char* lds, const bf16* P, bf16* mixed, const bf16* prevT_bh, const float* ret_norm_w, int b, int h, int nA, int nB, int tid, int lane, int wave, Hook hook, Hook2 hook2) {
    const int r32 = lane & 31, hi = lane >> 5;
    const size_t tA = (size_t)b * SEQ + nA * CH, tB = (size_t)b * SEQ + nB * CH;
    const bf16* pTA = prevT_bh + (size_t)nA * 8192; const bf16* pTB = prevT_bh + (size_t)nB * 8192;
    v4u kA[2], vA[4], pA[2], kB[2], vB[4], pB[2];
#pragma unroll
    for (int i = 0; i < 2; ++i) { const int id = tid + 512 * i, j = id >> 3, ch = id & 7; kA[i] = *(const v4u*)(P + PXT(O_RK >> 8, tA, h * 64) + (j * 256 + ch * 8)); pA[i] = *(const v4u*)(pTA + (size_t)j * 64 + ch * 8); }
#pragma unroll
    for (int i = 0; i < 4; ++i) { const int id = tid + 512 * i, j = id >> 4, ch = id & 15; vA[i] = *(const v4u*)(P + PXT((O_RV >> 8) + (h >> 1), tA, (h & 1) * 128) + (j * 256 + ch * 8)); }
    const int qb = (wave < 4) ? (wave >> 1) : 3 - ((wave - 4) >> 1), eh = wave & 1;
    bf16x8 qfA[4]; v4u gvA[4];
#pragma unroll
    for (int s = 0; s < 4; ++s) qfA[s] = *(const bf16x8*)(P + PXT(O_RQ >> 8, tA + 32 * qb, h * 64) + (r32 * 256 + s * 16 + hi * 8));
#pragma unroll
    for (int i = 0; i < 2; ++i) { const int id = tid + 512 * i, j = id >> 3, ch = id & 7; kB[i] = *(const v4u*)(P + PXT(O_RK >> 8, tB, h * 64) + (j * 256 + ch * 8)); pB[i] = *(const v4u*)(pTB + (size_t)j * 64 + ch * 8); }
#pragma unroll
    for (int i = 0; i < 4; ++i) { const int id = tid + 512 * i, j = id >> 4, ch = id & 15; vB[i] = *(const v4u*)(P + PXT((O_RV >> 8) + (h >> 1), tB, (h & 1) * 128) + (j * 256 + ch * 8)); }
#pragma unroll
    for (int i = 0; i < 4; ++i) gvA[i] = *(const v4u*)(P + PXT((O_RG >> 8) + (h >> 1), tA + 32 * qb, (h & 1) * 128 + 64 * eh) + ((i * 8 + (lane >> 3)) * 256 + (lane & 7) * 8));
    const f32x4 n0 = *(const f32x4*)(ret_norm_w + h * 128 + 64 * eh + (lane & 7) * 8), n1 = *(const f32x4*)(ret_norm_w + h * 128 + 64 * eh + (lane & 7) * 8 + 4);
#pragma unroll
    for (int i = 0; i < 2; ++i) { const int id = tid + 512 * i, j = id >> 3, ch = id & 7; const int off = j * 128 + ((ch ^ ((j >> 1) & 7)) << 4);
        *(LAS v4u*)(lds + KV_K + off) = kA[i]; *(LAS v4u*)(lds + RT_P + off) = pA[i]; }
#pragma unroll
    for (int i = 0; i < 4; ++i) { const int id = tid + 512 * i, j = id >> 4, ch = id & 15; *(LAS v4u*)(lds + KV_V + timg(j, ch, 8192)) = vA[i]; }
#pragma unroll
    for (int i = 0; i < 2; ++i) { const int id = tid + 512 * i, j = id >> 3, ch = id & 7; const int off = j * 128 + ((ch ^ ((j >> 1) & 7)) << 4);
        *(LAS v4u*)(lds + RP_B + KV_K + off) = kB[i]; *(LAS v4u*)(lds + RP_B + RT_P + off) = pB[i]; }
#pragma unroll
    for (int i = 0; i < 4; ++i) { const int id = tid + 512 * i, j = id >> 4, ch = id & 15; *(LAS v4u*)(lds + RP_B + KV_V + timg(j, ch, 8192)) = vB[i]; }
    asm volatile("" :: "v"(gvA[0]), "v"(gvA[1]), "v"(gvA[2]), "v"(gvA[3]), "v"(n0), "v"(n1), "v"(qfA[0]), "v"(qfA[1]), "v"(qfA[2]), "v"(qfA[3]));
    __syncthreads();
    hook();
    LAS f32x2_t* stats = (LAS f32x2_t*)(lds + RP_ST);
    LAS float* st = (LAS float*)(lds + (wave < 7 ? wave * RT_STG_STRIDE : RP_STG7));
    f32x16 o[2]; float mean64, m2;
    rp_compute(lds, qfA, o, qb, eh, r32, hi, lane);
    rp_stats(o, stats, mean64, m2, qb, eh, r32, hi);
    bf16x8 qfB[4]; v4u gvB[4];
#pragma unroll
    for (int s = 0; s < 4; ++s) qfB[s] = *(const bf16x8*)(P + PXT(O_RQ >> 8, tB + 32 * qb, h * 64) + (r32 * 256 + s * 16 + hi * 8));
#pragma unroll
    for (int i = 0; i < 4; ++i) gvB[i] = *(const v4u*)(P + PXT((O_RG >> 8) + (h >> 1), tB + 32 * qb, (h & 1) * 128 + 64 * eh) + ((i * 8 + (lane >> 3)) * 256 + (lane & 7) * 8));
    __syncthreads();
    rp_finish(o, stats, mean64, m2, st, gvA, n0, n1, mixed, tA + 32 * qb, h, qb, eh, r32, hi, lane);
    rp_compute(lds + RP_B, qfB, o, qb, eh, r32, hi, lane);
    rp_stats(o, stats + 256, mean64, m2, qb, eh, r32, hi);
    hook2();
    __syncthreads();
    rp_finish(o, stats + 256, mean64, m2, st, gvB, n0, n1, mixed, tB + 32 * qb, h, qb, eh, r32, hi, lane);
    __syncthreads();
}
}

__device__ __forceinline__ void grp_barrier(gu32* cnt, unsigned target, unsigned* tmo, int tid) {
    asm volatile("s_waitcnt vmcnt(0)" ::: "memory");
    __syncthreads();
    if (tid == 0) {
        (void)__hip_atomic_fetch_add((unsigned*)cnt, 1u, __ATOMIC_RELAXED, __HIP_MEMORY_SCOPE_AGENT);
        unsigned sp = 0;
        while (__hip_atomic_load((unsigned*)cnt, __ATOMIC_RELAXED, __HIP_MEMORY_SCOPE_AGENT) < target) {
            __builtin_amdgcn_s_sleep(1);
            if ((++sp & 255u) == 0u) { if (xb_ld(tmo)) break; if (sp > XB_SPIN_CAP) { atomicAdd(tmo, 1u); break; } }
        }
        __builtin_amdgcn_fence(__ATOMIC_ACQUIRE, "agent");
        asm volatile("s_waitcnt vmcnt(0)" ::: "memory");
    }
    __syncthreads();
}
__device__ __forceinline__ void grp_wait(gu32* cnt, unsigned target, unsigned* tmo, int tid) {
    if (tid == 0) {
        unsigned sp = 0;
        while (__hip_atomic_load((unsigned*)cnt, __ATOMIC_RELAXED, __HIP_MEMORY_SCOPE_AGENT) < target) {
            __builtin_amdgcn_s_sleep(1);
            if ((++sp & 255u) == 0u) { if (xb_ld(tmo)) break; if (sp > XB_SPIN_CAP) { atomicAdd(tmo, 1u); break; } }
        }
        __builtin_amdgcn_fence(__ATOMIC_ACQUIRE, "agent");
        asm volatile("s_waitcnt vmcnt(0)" ::: "memory");
    }
    __syncthreads();
}
__device__ __forceinline__ void grp_wait3(const gu32* c0, unsigned t0, const gu32* c1, unsigned t1, const gu32* c2, unsigned t2, unsigned* tmo) {
    if (threadIdx.x < 64) {
        const unsigned l = threadIdx.x; const gu32* c = l == 0 ? c0 : l == 1 ? c1 : c2; const unsigned t = l == 0 ? t0 : l == 1 ? t1 : t2;
        unsigned sp = 0;
        for (;;) {
            bool wait = false;
            if (l < 3) wait = __hip_atomic_load((const unsigned*)c, __ATOMIC_RELAXED, __HIP_MEMORY_SCOPE_AGENT) < t;
            if (__builtin_amdgcn_ballot_w64(wait) == 0ull) break;
            __builtin_amdgcn_s_sleep(1);
            if ((++sp & 255u) == 0u) { if (xb_ld(tmo)) break; if (sp > XB_SPIN_CAP) { if (l == 0) atomicAdd(tmo, 1u); break; } }
        }
        __builtin_amdgcn_fence(__ATOMIC_ACQUIRE, "agent");
        asm volatile("s_waitcnt vmcnt(0)" ::: "memory");
    }
    __syncthreads();
}
__device__ __forceinline__ void wg_arrive(gu32* cnt, unsigned v, int tid) {
    asm volatile("s_waitcnt vmcnt(0)" ::: "memory"); __syncthreads();
    if (tid == 0) (void)__hip_atomic_fetch_add((unsigned*)cnt, v, __ATOMIC_RELAXED, __HIP_MEMORY_SCOPE_AGENT);
}
struct OutOrder {
    pg8::StaticOrder so; const gu32* ready; unsigned need; unsigned* tmo;
    __device__ __forceinline__ bool next(int i, pg8::Unit& u) const { return so.next(i, u); }
    __device__ __forceinline__ void a_ready(const pg8::Unit& u) const {
        if (!ready) return;
        if (threadIdx.x < 64) {
            unsigned sp = 0;
            while ((unsigned)__builtin_amdgcn_readfirstlane(__hip_atomic_load((const unsigned*)(ready + 64 * u.pm), __ATOMIC_RELAXED, __HIP_MEMORY_SCOPE_AGENT)) < need) {
                __builtin_amdgcn_s_sleep(1);
                if ((++sp & 255u) == 0u) { if (xb_ld(tmo)) break; if (sp > XB_SPIN_CAP) { if (threadIdx.x == 0) atomicAdd(tmo, 1u); break; } }
            }
            __builtin_amdgcn_fence(__ATOMIC_ACQUIRE, "agent");
            asm volatile("s_waitcnt vmcnt(0)" ::: "memory");
        }
        asm volatile("" ::: "memory"); __builtin_amdgcn_s_barrier(); asm volatile("" ::: "memory");
    }
    __device__ __forceinline__ void done(const pg8::Unit&) const {}
};
struct ProjOrder {
    pg8::StaticOrder so; gu32* cnt; gu32* r3; const gu32* xr; unsigned* tmo;
    __device__ __forceinline__ bool next(int i, pg8::Unit& u) const { return so.next(i, u); }
    __device__ __forceinline__ void a_ready(const pg8::Unit& u) const {
        if (!xr || u.pn >= 4) return;
        if (threadIdx.x < 64) {
            unsigned sp = 0;
            while ((unsigned)__builtin_amdgcn_readfirstlane(__hip_atomic_load((const unsigned*)(xr + 64 * u.pm), __ATOMIC_RELAXED, __HIP_MEMORY_SCOPE_AGENT)) < 4u) {
                __builtin_amdgcn_s_sleep(1);
                if ((++sp & 255u) == 0u) { if (xb_ld(tmo)) break; if (sp > XB_SPIN_CAP) { if (threadIdx.x == 0) atomicAdd(tmo, 1u); break; } }
            }
            __builtin_amdgcn_fence(__ATOMIC_ACQUIRE, "agent");
            asm volatile("s_waitcnt vmcnt(0)" ::: "memory");
        }
        asm volatile("" ::: "memory"); __builtin_amdgcn_s_barrier(); asm volatile("" ::: "memory");
    }
    __device__ __forceinline__ void done(const pg8::Unit& u) const {
        if (cnt && u.pn >= 4 && u.pn < 8) {
            asm volatile("s_waitcnt vmcnt(0)" ::: "memory");
            if ((threadIdx.x & 63) == 0) (void)__hip_atomic_fetch_add((unsigned*)cnt, 1u, __ATOMIC_RELAXED, __HIP_MEMORY_SCOPE_AGENT);
        }
        if (r3 && u.pn >= 8) {
            asm volatile("s_waitcnt vmcnt(0)" ::: "memory");
            if ((threadIdx.x & 63) == 0) (void)__hip_atomic_fetch_add((unsigned*)(r3 + 64 * u.pm), 1u, __ATOMIC_RELAXED, __HIP_MEMORY_SCOPE_AGENT);
        }
    }
};
constexpr int N_PHASES = 5;
__global__ void __launch_bounds__(NWAVES * 64, 2) skel_fwd(Args args) {
    extern __shared__ __attribute__((aligned(16))) unsigned char lds[];
    unsigned cpf = 0u;
    {
        const unsigned long long pcb = __builtin_amdgcn_s_getpc();
        unsigned off;
        asm volatile("v_lshlrev_b32 %0, 6, %1" : "=v"(off) : "v"(threadIdx.x));
        asm volatile("global_load_dword %0, %1, %2" : "+v"(cpf) : "v"(off), "s"(pcb) : "memory");
        asm volatile("global_load_dword %0, %1, %2" : "+v"(cpf) : "v"(off), "s"(pcb + 32768ull) : "memory");
        asm volatile("global_load_dword %0, %1, %2" : "+v"(cpf) : "v"(off), "s"(pcb + 65536ull) : "memory");
        asm volatile("global_load_dword %0, %1, %2" : "+v"(cpf) : "v"(off), "s"(pcb + 98304ull) : "memory");
        asm volatile("global_load_dword %0, %1, %2" : "+v"(cpf) : "v"(off), "s"(pcb + 101376ull) : "memory");
    }
    Frame F;
    F.lds = (LAS unsigned char*)lds;
    F.MISC = (volatile LAS unsigned*)(F.lds + MISC_OFF);
    F.tid = threadIdx.x; F.lane = F.tid & 63; F.wave = __builtin_amdgcn_readfirstlane(F.tid >> 6);
    F.G = gridDim.x; { const int bx = blockIdx.x; F.vcu = (F.G % 8 == 0) ? (bx % 8) * (F.G / 8) + bx / 8 : bx; }
    unsigned char* ws = args.ws;
    F.ctl = (gu32*)(ws + WS_CTL);
    for (int u = F.tid; u < (LDS_BYTES - LDSCTL_OFF) / 4; u += NWAVES * 64) ((LAS unsigned*)(F.lds + LDSCTL_OFF))[u] = 0u;
    __syncthreads();
    XcdBarrier bar = xcd_barrier_post((unsigned*)(F.ctl + CW_BAR) + args.li * XCD_BAR_WORDS, F.MISC + 8);
    const int lo = args.ph_lo, hi = args.ph_hi;
#define IN(k) (lo <= (k) && (k) < hi)
#define BOTH(k) (IN(k) && IN((k) + 1))

    const int grp = F.vcu >> 5, jg = F.vcu & 31;
    const bool map256 = (F.G == 256);
    if (F.tid == 0 && map256) (void)__hip_atomic_fetch_or((unsigned*)(F.ctl + CW_XMASK + 64 * grp), 1u << bar.x, __ATOMIC_RELAXED, __HIP_MEMORY_SCOPE_AGENT);
    unsigned* const gtmo = (unsigned*)(F.ctl + CW_BAR) + XB_TMO;
    const bool full = map256 && lo == 0 && hi == N_PHASES;
    gu32* const wcnt = F.ctl + CW_GRP + (4 * 8 + 0) * 64;
    if (IN(0)) {
        if (full) { p0_split(F, args, grp, jg, wcnt); grp_wait(wcnt, (unsigned)F.G, gtmo, F.tid); }
        else { p0_prologue(F, args); if (BOTH(0)) xcd_barrier(bar); }
    }
    asm volatile("s_waitcnt vmcnt(0)" :: "v"(cpf) : "memory");
    if (F.tid == 0) {
        unsigned mk[8];
#pragma unroll
        for (int g8 = 0; g8 < 8; ++g8) mk[g8] = __hip_atomic_load((unsigned*)(F.ctl + CW_XMASK + 64 * g8), __ATOMIC_RELAXED, __HIP_MEMORY_SCOPE_AGENT);
        unsigned ok = full ? 1u : 0u;
#pragma unroll
        for (int g8 = 0; g8 < 8; ++g8) if (__builtin_popcount(mk[g8]) != 1) ok = 0u;
        F.MISC[12] = ok;
    }
    __syncthreads();
    const bool glocal = F.MISC[12] != 0u;
#define SEAM(inst) do { if (glocal) grp_barrier(F.ctl + CW_GRP + ((inst) * 8 + grp) * 64, 32u, gtmo, F.tid); else xcd_barrier(bar); } while (0)
    if (full && IN(0)) { if (glocal) wg_arrive(F.ctl + CW_X + 64 * (grp * 8 + (jg & 7)), 1u, F.tid); else SEAM(3); }

    f32x4 noinit[2][2][4][2];

    if (IN(1)) {
        pg8::Gemm g{(const bf16*)(ws + WS_XB), (const bf16*)(ws + WS_W1), T, DIN, DM};
        ProjOrder S; S.so.init(T, DIN, F.G, (int)blockIdx.x);
 S.cnt = glocal ? F.ctl + CW_GRP + (0 * 8 + grp) * 64 : nullptr; S.r3 = glocal ? F.ctl + CW_R3 : nullptr; S.xr = (glocal && IN(0)) ? (const gu32*)(F.ctl + CW_X) : nullptr; S.tmo = gtmo;
        pg8::EpiProj E{(bf16*)(ws + WS_P), (const float*)(ws + WS_RSTD), args.in[4], args.in[5], args.lg2g[0], args.lg2g[1], args.lg2g[2], args.lg2g[3], 0};
        pg8::gemm_phase<pg8::EpiProj, ProjOrder, true, true>(F.lds + RING_OFF, g, S, E, noinit);
        if (!glocal && BOTH(1)) xcd_barrier(bar);
    }
    int dp0 = -1, dp1 = -1; unsigned dc1 = 0u;
    if (IN(2)) {
        const bf16* Pb = (const bf16*)(ws + WS_P); bf16* mixed = (bf16*)(ws + WS_MIX); Tabs tb = tabs_of(ws);
        if (map256) {
            int su = -1, pu = -1;
            if (glocal) { if (jg >= 24) { su = jg - 24; pu = jg - 24; grp_wait(F.ctl + CW_GRP + (0 * 8 + grp) * 64, 256u, gtmo, F.tid); } }
            else { if (jg < 8) su = jg; else if (jg < 16) pu = jg - 8; }
            if (pu >= 0) { const int h = pu >> 1; const float gC = h == 0 ? args.g128[0] : h == 1 ? args.g128[1] : h == 2 ? args.g128[2] : args.g128[3];
                mid::prefix_unit(F.lds, Pb, (bf16*)(ws + WS_PREV) + (size_t)(grp * 4 + h) * NCH * 8192, gC, grp, h, pu & 1, F.tid, F.lane, F.wave);
                if (glocal) wg_arrive(F.ctl + CW_PFX + 64 * (grp * 4 + h), 1u, F.tid); }
            if (su >= 0) { mid::swa_units(F.lds, Pb, mixed, tb.biasT, args.in[6], grp, su, 1, 0, 2, F.tid, F.lane, F.wave); if (glocal) dp0 = grp * 8 + (su >> 2); }
        } else {
            for (int u = F.vcu; u < BATCH * NCH * SKV; u += F.G) mid::swa_units(F.lds, Pb, mixed, tb.biasT, args.in[6], u >> 5, u & 31, 1, 0, 2, F.tid, F.lane, F.wave);
            for (int u = F.vcu; u < BATCH * RH * 2; u += F.G) { const int h = (u >> 1) & 3; const float gC = h == 0 ? args.g128[0] : h == 1 ? args.g128[1] : h == 2 ? args.g128[2] : args.g128[3];
                mid::prefix_unit(F.lds, Pb, (bf16*)(ws + WS_PREV) + (size_t)(u >> 1) * NCH * 8192, gC, u >> 3, h, u & 1, F.tid, F.lane, F.wave); }
        }
        if (map256 && glocal && jg < 24) grp_wait(F.ctl + CW_GRP + (0 * 8 + grp) * 64, 256u, gtmo, F.tid);
        if (map256) {
            const int su3 = (jg < 16) ? 8 + jg : 24 + ((jg - 16) >> 1);
            if (jg < 16) mid::swa_units(F.lds, Pb, mixed, tb.biasT, args.in[6], grp, su3, 1, 0, 2, F.tid, F.lane, F.wave);
            else mid::swa_units(F.lds, Pb, mixed, tb.biasT, args.in[6], grp, su3, 1, jg & 1, (jg & 1) + 1, F.tid, F.lane, F.wave);
            if (glocal) { dp1 = grp * 8 + (su3 >> 2); dc1 = (jg < 16) ? 2u : 1u; } }
        if (BOTH(2) && !glocal) SEAM(1);
    }

    if (full) {
        const bf16* Pb = (const bf16*)(ws + WS_P); bf16* mixed = (bf16*)(ws + WS_MIX);
        pg8::StaticOrder so4; so4.init(T, DM, F.G, (int)blockIdx.x); pg8::Unit u4; u4.pm = 0; u4.pn = 0; (void)so4.next(0, u4);
        const int pm4 = u4.pm, pn4 = u4.pn;
        f32x4 xacc[2][2][4][2];
        {
            const int bh = F.vcu >> 3, j = F.vcu & 7, nA = j, nB = 15 - j, h = bh & 3, b = bh >> 2;
            if (glocal) grp_wait3(F.ctl + CW_PFX + 64 * bh, 2u, F.ctl + CW_R3 + 64 * (b * 8 + (nA >> 1)), 24u, F.ctl + CW_R3 + 64 * (b * 8 + (nB >> 1)), 24u, gtmo);
            const int wr4 = F.wave >> 2, wc4 = F.wave & 3, fr4 = F.lane & 15, fq4 = F.lane >> 4;
            const float* xb = args.in[0] + (size_t)(pm4 * 256 + wr4 * 64 + fr4) * DM + pn4 * 256 + wc4 * 32 + 4 * fq4;
            auto xquad = [&](int ai, int bj) {
#pragma unroll
                for (int m = 0; m < 4; ++m)
#pragma unroll
                    for (int n = 0; n < 2; ++n) xacc[ai][bj][m][n] = __builtin_nontemporal_load((const f32x4*)(xb + (size_t)(ai * 128 + m * 16) * DM + bj * 128 + n * 16));
            };
            mid::ret_pair(F.lds, Pb, mixed, (const bf16*)(ws + WS_PREV) + (size_t)bh * NCH * 8192, args.in[3], b, h, nA, nB, F.tid, F.lane, F.wave, [&] { xquad(0, 0); xquad(0, 1); xquad(1, 0); }, [&] { xquad(1, 1); });
            if (glocal) {
                asm volatile("s_waitcnt vmcnt(0)" ::: "memory"); __syncthreads();
                if (F.tid == 0) { (void)__hip_atomic_fetch_add((unsigned*)(F.ctl + CW_PAN + 64 * (b * 8 + (nA >> 1))), 1u, __ATOMIC_RELAXED, __HIP_MEMORY_SCOPE_AGENT);
                                  (void)__hip_atomic_fetch_add((unsigned*)(F.ctl + CW_PAN + 64 * (b * 8 + (nB >> 1))), 1u, __ATOMIC_RELAXED, __HIP_MEMORY_SCOPE_AGENT);
                                  if (dp0 >= 0) (void)__hip_atomic_fetch_add((unsigned*)(F.ctl + CW_PAN + 64 * dp0), 2u, __ATOMIC_RELAXED, __HIP_MEMORY_SCOPE_AGENT);
                                  if (dp1 >= 0) (void)__hip_atomic_fetch_add((unsigned*)(F.ctl + CW_PAN + 64 * dp1), dc1, __ATOMIC_RELAXED, __HIP_MEMORY_SCOPE_AGENT); }
            } else SEAM(2);
        }
        pg8::Gemm g{(const bf16*)(ws + WS_MIX), (const bf16*)(ws + WS_W2), T, DM, DMIX}; OutOrder S; S.so.init(T, DM, F.G, (int)blockIdx.x); S.ready = glocal ? (const gu32*)(F.ctl + CW_PAN) : nullptr; S.need = 16u; S.tmo = gtmo;
        pg8::EpiRes E{args.in[0], args.out, DM, pm4, pn4};
        pg8::gemm_phase<pg8::EpiRes, OutOrder, true, true, true>(F.lds + RING_OFF, g, S, E, xacc);
    } else {
        if (IN(3)) {
            const bf16* Pb = (const bf16*)(ws + WS_P); bf16* mixed = (bf16*)(ws + WS_MIX);
            for (int u = F.vcu; u < BATCH * RH * NCH; u += F.G) {
                const int bh = (u & 255) >> 3, j = u & 7, n = (u < 256) ? j : 15 - j, h = bh & 3, b = bh >> 2;
                mid::ret_unit(F.lds, Pb, mixed, (const bf16*)(ws + WS_PREV) + ((size_t)bh * NCH + n) * 8192, args.in[3], b, h, n, F.tid, F.lane, F.wave, [] {});
            }
            if (BOTH(3)) xcd_barrier(bar);
        }
        if (IN(4)) {
            pg8::Gemm g{(const bf16*)(ws + WS_MIX), (const bf16*)(ws + WS_W2), T, DM, DMIX}; OutOrder S; S.so.init(T, DM, F.G, (int)blockIdx.x); S.ready = nullptr; S.need = 16u; S.tmo = gtmo;
            pg8::EpiRes E{args.in[0], args.out, DM, -1, -1};
            pg8::gemm_phase<pg8::EpiRes, OutOrder, true, true>(F.lds + RING_OFF, g, S, E, noinit);
        }
    }
#undef IN
#undef BOTH
}

extern "C" void kernel_launch(void* const* d_in, const int* in_sizes, int n_in, void* d_out, int out_size, void* d_ws, size_t ws_size, hipStream_t stream) {
    static int grid = 0;
    if (grid == 0) {
        if (n_in != 9 || in_sizes[0] != T * DM || out_size != T * DM || ws_size < WS_END) { fprintf(stderr, "kernel_launch: unexpected shapes (n_in %d, ws %zu)\n", n_in, ws_size); grid = -1; return; }
        int dev = 0, cus = 0, per_cu = 0;
        if (hipGetDevice(&dev) != hipSuccess || hipDeviceGetAttribute(&cus, hipDeviceAttributeMultiprocessorCount, dev) != hipSuccess) { grid = -1; return; }
        if (hipFuncSetAttribute((const void*)skel_fwd, hipFuncAttributeMaxDynamicSharedMemorySize, LDS_BYTES) != hipSuccess) { fprintf(stderr, "kernel_launch: hipFuncSetAttribute failed\n"); grid = -1; return; }
        if (hipOccupancyMaxActiveBlocksPerMultiprocessor(&per_cu, (const void*)skel_fwd, NWAVES * 64, LDS_BYTES) != hipSuccess || per_cu < 1) { fprintf(stderr, "kernel_launch: occupancy query says %d blocks per CU\n", per_cu); grid = -1; return; }
        (void)hipGetLastError();
        grid = cus * 1;
    }
    if (grid < 0) return;
    (void)hipMemsetAsync((char*)d_ws + WS_CTL, 0, CTL_ZERO_BYTES, stream);
    Args a{};
    for (int i = 0; i < 9; ++i) a.in[i] = (const float*)d_in[i];
    a.out = (float*)d_out; a.ws = (unsigned char*)d_ws;
    for (int h = 0; h < 4; ++h) { const double g = 1.0 - std::exp2(-5.0 - h); a.lg2g[h] = (float)std::log2(g); a.g128[h] = (float)std::pow(g, 128.0); }
    a.ph_lo = 0; a.ph_hi = N_PHASES; a.li = 0;
    hipLaunchKernelGGL(skel_fwd, dim3(grid), dim3(NWAVES * 64), LDS_BYTES, stream, a);
}
```
